# Optimizing an MI355X kernel written in HIP

```python
import math
import jax, jax.numpy as jnp
from jax import lax
import numpy as np

D_MODEL = 1024
BATCH = 8
SEQ = 8192
DEPTH = 2

HEAD_DIM = 64
A_HEADS = 4
IDX_HEADS = 8
IDX_DIM = 64
DSA_TOPK_MAX = 256
DSA_IDX_SCALE = (IDX_HEADS ** -0.5) * (IDX_DIM ** -0.5)
B_HEADS = 4
MOBA_BLOCK = 256
MOBA_TOPK = 3
MOBA_Q_CHUNK = 64
C_HEADS = 8
Q_BLOCK = 128
D_FF = 2816
ROPE_THETA = 10000.0
RMS_EPS = 1e-6

A_WIDTH = A_HEADS * HEAD_DIM
B_WIDTH = B_HEADS * HEAD_DIM
C_WIDTH = C_HEADS * HEAD_DIM
MIX_WIDTH = A_WIDTH + B_WIDTH + C_WIDTH
IN_SIZES = (A_WIDTH, HEAD_DIM, HEAD_DIM, IDX_HEADS * IDX_DIM, IDX_DIM, IDX_HEADS,
            B_WIDTH, B_WIDTH, B_WIDTH,
            C_WIDTH, C_WIDTH, C_WIDTH, C_HEADS, C_WIDTH)
IN_WIDTH = sum(IN_SIZES)

kernel_name = "hybrid_dsa_moba_fox_macaron"


def rms_norm(x, g):
    xf = x.astype(jnp.float32)
    y = xf * lax.rsqrt(jnp.mean(xf * xf, axis=-1, keepdims=True) + RMS_EPS)
    return (y * g.astype(jnp.float32)).astype(x.dtype)


def rope_tables(seq, dim):
    inv = 1.0 / (ROPE_THETA ** (jnp.arange(0, dim, 2, dtype=jnp.float32) / dim))
    ang = jnp.arange(seq, dtype=jnp.float32)[:, None] * inv[None, :]
    return jnp.cos(ang), jnp.sin(ang)


def apply_rope(x, cos, sin):
    x1, x2 = jnp.split(x.astype(jnp.float32), 2, axis=-1)
    c = cos[None, :, None, :]
    s = sin[None, :, None, :]
    return jnp.concatenate([x1 * c - x2 * s, x2 * c + x1 * s], axis=-1).astype(x.dtype)


def swiglu(x, w_gate, w_up, w_down):
    return (jax.nn.silu(x @ w_gate) * (x @ w_up)) @ w_down


def dsa_attention(q, k, v, qi, ki, wi):
    B, S, H, D = q.shape
    topk = min(DSA_TOPK_MAX, S // 4)
    scale = D ** -0.5
    key_pos = jnp.arange(S)
    ki_f = ki.astype(jnp.float32)

    def block(i):
        q0 = i * Q_BLOCK
        qb = lax.dynamic_slice_in_dim(q, q0, Q_BLOCK, 1)
        qib = lax.dynamic_slice_in_dim(qi, q0, Q_BLOCK, 1).astype(jnp.float32)
        wib = lax.dynamic_slice_in_dim(wi, q0, Q_BLOCK, 1).astype(jnp.float32)
        qpos = q0 + jnp.arange(Q_BLOCK)
        causal = key_pos[None, :] <= qpos[:, None]
        idx_logits = jnp.einsum('bqhe,bse->bqhs', qib, ki_f)
        score = jnp.einsum('bqh,bqhs->bqs', wib * DSA_IDX_SCALE, jax.nn.relu(idx_logits))
        score = jnp.where(causal[None], score, -jnp.inf)
        _, sel = lax.top_k(score, topk)
        valid = sel <= qpos[None, :, None]
        kg = jax.vmap(lambda kk, ii: kk[ii])(k, sel)
        vg = jax.vmap(lambda vv, ii: vv[ii])(v, sel)
        s = jnp.einsum('bqhd,bqkd->bhqk', qb, kg).astype(jnp.float32) * scale
        s = jnp.where(valid[:, None], s, -jnp.inf)
        p = jax.nn.softmax(s, axis=-1).astype(v.dtype)
        return jnp.einsum('bhqk,bqkd->bqhd', p, vg)

    out = lax.map(block, jnp.arange(S // Q_BLOCK))
    return out.transpose(1, 0, 2, 3, 4).reshape(B, S, H * D)


def moba_attention(q, k, v):
    B, S, H, D = q.shape
    scale = D ** -0.5
    nblk = -(-S // MOBA_BLOCK)
    pad = nblk * MOBA_BLOCK - S
    kp = jnp.pad(k, ((0, 0), (0, pad), (0, 0), (0, 0)))
    vp = jnp.pad(v, ((0, 0), (0, pad), (0, 0), (0, 0)))
    kbh = kp.reshape(B, nblk, MOBA_BLOCK, H, D).transpose(0, 3, 1, 2, 4)
    vbh = vp.reshape(B, nblk, MOBA_BLOCK, H, D).transpose(0, 3, 1, 2, 4)
    kmean = jnp.mean(kbh.astype(jnp.float32), axis=3)
    n_sel = min(MOBA_TOPK, nblk - 1)
    blk_ids = jnp.arange(nblk)
    in_blk = jnp.arange(MOBA_BLOCK)

    def chunk(i):
        q0 = i * MOBA_Q_CHUNK
        own = q0 // MOBA_BLOCK
        qb = lax.dynamic_slice_in_dim(q, q0, MOBA_Q_CHUNK, 1)
        qpos = q0 + jnp.arange(MOBA_Q_CHUNK)
        k_own = lax.dynamic_index_in_dim(kbh, own, 2, keepdims=False)
        v_own = lax.dynamic_index_in_dim(vbh, own, 2, keepdims=False)
        own_pos = own * MOBA_BLOCK + in_blk
        s_own = jnp.einsum('bqhd,bhkd->bhqk', qb, k_own).astype(jnp.float32) * scale
        s_own = jnp.where((own_pos[None, :] <= qpos[:, None])[None, None], s_own, -jnp.inf)
        if n_sel == 0:
            p = jax.nn.softmax(s_own, axis=-1).astype(v.dtype)
            return jnp.einsum('bhqk,bhkd->bqhd', p, v_own)
        gate = jnp.einsum('bqhd,bhnd->bhqn', qb.astype(jnp.float32), kmean)
        gate = jnp.where((blk_ids < own)[None, None, None], gate, -jnp.inf)
        _, sel = lax.top_k(gate, n_sel)
        valid = sel < own
        gather = jax.vmap(jax.vmap(lambda kk, ii: kk[ii]))
        kg = gather(kbh, sel)
        vg = gather(vbh, sel)
        s_sel = jnp.einsum('bqhd,bhqnkd->bhqnk', qb, kg).astype(jnp.float32) * scale
        s_sel = jnp.where(valid[..., None], s_sel, -jnp.inf)
        s_sel = s_sel.reshape(B, H, MOBA_Q_CHUNK, n_sel * MOBA_BLOCK)
        p = jax.nn.softmax(jnp.concatenate([s_sel, s_own], axis=-1), axis=-1).astype(v.dtype)
        p_sel = p[..., :n_sel * MOBA_BLOCK].reshape(B, H, MOBA_Q_CHUNK, n_sel, MOBA_BLOCK)
        p_own = p[..., n_sel * MOBA_BLOCK:]
        return (jnp.einsum('bhqnk,bhqnkd->bqhd', p_sel, vg)
                + jnp.einsum('bhqk,bhkd->bqhd', p_own, v_own))

    out = lax.map(chunk, jnp.arange(S // MOBA_Q_CHUNK))
    return out.transpose(1, 0, 2, 3, 4).reshape(B, S, H * D)


def forgetting_attention(q, k, v, log_f):
    B, S, H, D = q.shape
    scale = D ** -0.5
    c = jnp.cumsum(log_f, axis=1).transpose(0, 2, 1)
    key_pos = jnp.arange(S)

    def block(i):
        q0 = i * Q_BLOCK
        qb = lax.dynamic_slice_in_dim(q, q0, Q_BLOCK, 1)
        cq = lax.dynamic_slice_in_dim(c, q0, Q_BLOCK, 2)
        qpos = q0 + jnp.arange(Q_BLOCK)
        s = jnp.einsum('bqhd,bkhd->bhqk', qb, k).astype(jnp.float32) * scale
        s = s + cq[..., None] - c[:, :, None, :]
        s = jnp.where((key_pos[None, :] <= qpos[:, None])[None, None], s, -jnp.inf)
        p = jax.nn.softmax(s, axis=-1).astype(v.dtype)
        return jnp.einsum('bhqk,bkhd->bqhd', p, v)

    out = lax.map(block, jnp.arange(S // Q_BLOCK))
    return out.transpose(1, 0, 2, 3, 4).reshape(B, S, H * D)


def hybrid_mixer(u, w_in, forget_bias, a_q_norm, a_k_norm, b_q_norm, b_k_norm,
                 c_q_norm, c_k_norm, w_out, cos, sin):
    B, S, _ = u.shape
    proj = u @ w_in
    splits = np.cumsum(np.array(IN_SIZES))[:-1].tolist()
    (aq, ak, av, iq, ik, iw, bq, bk, bv, cq, ck, cv, cf, cg) = jnp.split(proj, splits, axis=-1)

    aq = apply_rope(rms_norm(aq.reshape(B, S, A_HEADS, HEAD_DIM), a_q_norm), cos, sin)
    ak = apply_rope(rms_norm(ak.reshape(B, S, 1, HEAD_DIM), a_k_norm), cos, sin)[:, :, 0]
    iq = apply_rope(iq.reshape(B, S, IDX_HEADS, IDX_DIM), cos, sin)
    ik = apply_rope(ik.reshape(B, S, 1, IDX_DIM), cos, sin)[:, :, 0]
    o_a = dsa_attention(aq, ak, av, iq, ik, iw)

    bq = apply_rope(rms_norm(bq.reshape(B, S, B_HEADS, HEAD_DIM), b_q_norm), cos, sin)
    bk = apply_rope(rms_norm(bk.reshape(B, S, B_HEADS, HEAD_DIM), b_k_norm), cos, sin)
    o_b = moba_attention(bq, bk, bv.reshape(B, S, B_HEADS, HEAD_DIM))

    cq = rms_norm(cq.reshape(B, S, C_HEADS, HEAD_DIM), c_q_norm)
    ck = rms_norm(ck.reshape(B, S, C_HEADS, HEAD_DIM), c_k_norm)
    log_f = jax.nn.log_sigmoid(cf.astype(jnp.float32) + forget_bias.astype(jnp.float32))
    o_c = forgetting_attention(cq, ck, cv.reshape(B, S, C_HEADS, HEAD_DIM), log_f)
    o_c = o_c * jax.nn.sigmoid(cg)

    return jnp.concatenate([o_a, o_b, o_c], axis=-1) @ w_out


def setup_inputs(seed: int = 0) -> dict:
    key = jax.random.key(seed)
    ks = jax.random.split(key, 24)

    def w(k, shape, fan_in):
        return jax.random.normal(k, shape, jnp.float32) * (fan_in ** -0.5)

    def gain(k, shape):
        return 1.0 + 0.05 * jax.random.normal(k, shape, jnp.float32)

    return {
        "x": jax.random.normal(ks[0], (BATCH, SEQ, D_MODEL), jnp.float32),
        "ffn1_norm": gain(ks[1], (DEPTH, D_MODEL)),
        "ffn1_w_gate": w(ks[2], (DEPTH, D_MODEL, D_FF), D_MODEL),
        "ffn1_w_up": w(ks[3], (DEPTH, D_MODEL, D_FF), D_MODEL),
        "ffn1_w_down": w(ks[4], (DEPTH, D_FF, D_MODEL), D_FF),
        "mix_norm": gain(ks[5], (DEPTH, D_MODEL)),
        "w_in": w(ks[6], (DEPTH, D_MODEL, IN_WIDTH), D_MODEL),
        "forget_bias": jax.random.uniform(ks[7], (DEPTH, C_HEADS), jnp.float32, 1.0, 4.0),
        "a_q_norm": gain(ks[8], (DEPTH, HEAD_DIM)),
        "a_k_norm": gain(ks[9], (DEPTH, HEAD_DIM)),
        "b_q_norm": gain(ks[10], (DEPTH, HEAD_DIM)),
        "b_k_norm": gain(ks[11], (DEPTH, HEAD_DIM)),
        "c_q_norm": gain(ks[12], (DEPTH, HEAD_DIM)),
        "c_k_norm": gain(ks[13], (DEPTH, HEAD_DIM)),
        "w_out": w(ks[14], (DEPTH, MIX_WIDTH, D_MODEL), MIX_WIDTH),
        "ffn2_norm": gain(ks[15], (DEPTH, D_MODEL)),
        "ffn2_w_gate": w(ks[16], (DEPTH, D_MODEL, D_FF), D_MODEL),
        "ffn2_w_up": w(ks[17], (DEPTH, D_MODEL, D_FF), D_MODEL),
        "ffn2_w_down": w(ks[18], (DEPTH, D_FF, D_MODEL), D_FF),
    }


def reference(x, ffn1_norm, ffn1_w_gate, ffn1_w_up, ffn1_w_down, mix_norm, w_in, forget_bias,
              a_q_norm, a_k_norm, b_q_norm, b_k_norm, c_q_norm, c_k_norm, w_out,
              ffn2_norm, ffn2_w_gate, ffn2_w_up, ffn2_w_down):
    S = x.shape[1]
    cos, sin = rope_tables(S, HEAD_DIM)
    h = x
    for l in range(DEPTH):
        h = h + 0.5 * swiglu(rms_norm(h, ffn1_norm[l]), ffn1_w_gate[l], ffn1_w_up[l], ffn1_w_down[l])
        h = h + hybrid_mixer(rms_norm(h, mix_norm[l]), w_in[l], forget_bias[l],
                             a_q_norm[l], a_k_norm[l], b_q_norm[l], b_k_norm[l],
                             c_q_norm[l], c_k_norm[l], w_out[l], cos, sin)
        h = h + 0.5 * swiglu(rms_norm(h, ffn2_norm[l]), ffn2_w_gate[l], ffn2_w_up[l], ffn2_w_down[l])
    return h
```

```cpp
#include <hip/hip_runtime.h>
#include <hip/hip_cooperative_groups.h>
#include <cstdio>
#include <cstdint>
namespace cg = cooperative_groups;
namespace pg8 {
#define PG8_LAS __attribute__((address_space(3)))
typedef unsigned short bf16_t;
typedef short bf16x8 __attribute__((ext_vector_type(8)));
typedef float f32x4 __attribute__((ext_vector_type(4)));
typedef unsigned u32x4 __attribute__((ext_vector_type(4)));
constexpr int BM = 256, BK = 64, HALF = 128, HTB = HALF * BK * 2  , STAGE_BYTES = 8 * HTB, NXCD = 8, WGM = 8;

__host__ __device__ __forceinline__ int lds_byte(int r, int c) { const int st = (r >> 4) * 2 + (c >> 5), rr = r & 15, cc = c & 31, ob = rr * 64 + cc * 2; return st * 1024 + (ob ^ (((ob >> 9) & 1) << 5)); }
__host__ __device__ __forceinline__ void stage_rc(int b, int& R, int& C) { const int st = b / 1024, sb = b % 1024, swz = sb ^ (((sb >> 9) & 1) << 5); R = (st >> 1) * 16 + swz / 64; C = (st & 1) * 32 + (swz % 64) / 2; }
__host__ __device__ __forceinline__ int perm32(int rho) { const int n = rho >> 4, i = rho & 15; return 8 * (i >> 2) + 4 * n + (i & 3); }

struct Unit { int pm, pn; };
struct Gemm { const bf16_t* A; const bf16_t* Bt; int M, N, K; };

struct StaticOrder {
    int nM, nN, nwg, G, c;
    __host__ __device__ void init(int M, int N, int G_, int c_) { nM = M / BM; nN = N / BM; nwg = nM * nN; G = G_; c = c_; }
    __host__ __device__ bool next(int i, Unit& u) const {
        const long L = (long)i * G + c; if (L >= nwg) return false;
        int wgid = (int)L; { const int q = nwg / NXCD, r = nwg % NXCD, xcd = wgid % NXCD, off = wgid / NXCD; wgid = (xcd < r ? xcd * (q + 1) : r * (q + 1) + (xcd - r) * q) + off; }
        const int nig = WGM * nN, gid = wgid / nig, fm = gid * WGM, gsz = (nM - fm) < WGM ? (nM - fm) : WGM;
        u.pm = fm + ((wgid % nig) % gsz); u.pn = (wgid % nig) / gsz; return true;
    }
    __device__ __forceinline__ void a_ready(const Unit&) const {}
    __device__ __forceinline__ void done(const Unit&) const {}
};

__device__ __forceinline__ unsigned cvt_pk_bf16(float lo, float hi) { unsigned r; asm volatile("v_cvt_pk_bf16_f32 %0, %1, %2" : "=v"(r) : "v"(lo), "v"(hi)); return r; }
template <class Epi, class Sched, bool ALIGN_EPI = false, bool SP2 = false>
__device__ __forceinline__ void gemm_phase(PG8_LAS unsigned char* lds, const Gemm g, const Sched& S, const Epi& E) {
    const int tid = threadIdx.x, wid = __builtin_amdgcn_readfirstlane(tid >> 6), lane = tid & 63, wr = wid >> 2, wc = wid & 3, fr = lane & 15, fq = lane >> 4;
    const int K = g.K, nt = K / BK;
    unsigned voffA[2], voffB[2];
#pragma unroll
    for (int i = 0; i < 2; ++i) { int R, C; stage_rc(tid * 16 + i * 8192, R, C); const int Rb = Epi::PERM ? ((R & ~31) + perm32(R & 31)) : R;
        voffA[i] = (unsigned)(R * K + C) * 2u; voffB[i] = (unsigned)(Rb * K + C) * 2u; }
    const size_t kstep = (size_t)(BK * 2);
    const size_t hstep = (size_t)HALF * K * 2;
    const size_t tstep = 2 * hstep;
    const unsigned ldsw = (unsigned)wid * 1024u;
    const int aoff = lds_byte(wr * 64 + fr, fq * 8), boff = lds_byte(wc * 32 + fr, fq * 8);
#define PG8_SA(b, h) (((b) * 2 + (h)) * HTB)
#define PG8_SB(b, h) ((4 + (b) * 2 + (h)) * HTB)
#define PG8_STAGE(bufoff, gbase, voff) do { _Pragma("unroll") for (int _i = 0; _i < 2; ++_i) \
        __builtin_amdgcn_global_load_lds((const unsigned*)((const char*)(gbase) + (voff)[_i]), (PG8_LAS unsigned*)(lds + (bufoff) + ldsw + _i * 8192), 16, 0, 0); } while (0)
#define PG8_LDA(dst, b, h) do { _Pragma("unroll") for (int m = 0; m < 4; ++m) _Pragma("unroll") for (int k = 0; k < 2; ++k) dst[m][k] = *(const PG8_LAS bf16x8*)(lds + PG8_SA(b, h) + aoff + m * 2048 + k * 1024); } while (0)
#define PG8_LDB(dst, b, h) do { _Pragma("unroll") for (int n = 0; n < 2; ++n) _Pragma("unroll") for (int k = 0; k < 2; ++k) dst[n][k] = *(const PG8_LAS bf16x8*)(lds + PG8_SB(b, h) + boff + n * 2048 + k * 1024); } while (0)
#define PG8_MMA(ai, bj, At, Bt) do { __builtin_amdgcn_s_setprio(1); _Pragma("unroll") for (int m = 0; m < 4; ++m) _Pragma("unroll") for (int n = 0; n < 2; ++n) _Pragma("unroll") for (int k = 0; k < 2; ++k) \
        acc[ai][bj][m][n] = __builtin_amdgcn_mfma_f32_16x16x32_bf16(Bt[n][k], At[m][k], acc[ai][bj][m][n], 0, 0, 0); __builtin_amdgcn_s_setprio(0); } while (0)
#define PG8_WAIT_V(n) asm volatile("s_waitcnt vmcnt(" #n ")" ::: "memory")
#define PG8_WAIT_L(n) asm volatile("s_waitcnt lgkmcnt(" #n ")" ::: "memory")
#define PG8_BAR __builtin_amdgcn_s_barrier()
#define PG8_SCHED __builtin_amdgcn_sched_barrier(0)
    Unit cur, nxt; int ui = 0;
    if (!S.next(0, cur)) return;
    f32x4 acc[2][2][4][2];
#pragma unroll
    for (int a = 0; a < 2; ++a)
#pragma unroll
        for (int b = 0; b < 2; ++b)
#pragma unroll
            for (int m = 0; m < 4; ++m)
#pragma unroll
                for (int n = 0; n < 2; ++n) acc[a][b][m][n] = (f32x4){0.f, 0.f, 0.f, 0.f};
    bf16x8 At[4][2], B0[2][2], B1[2][2];
    const char* cA = (const char*)g.A + (size_t)cur.pm * tstep; const char* cB = (const char*)g.Bt + (size_t)cur.pn * tstep;
    S.a_ready(cur);
    if constexpr (SP2) {
        PG8_STAGE(PG8_SB(0, 0), cB, voffB); PG8_STAGE(PG8_SB(0, 1), cB + hstep, voffB); PG8_STAGE(PG8_SA(0, 0), cA, voffA); PG8_STAGE(PG8_SA(0, 1), cA + hstep, voffA);
        if (wr == 1) PG8_BAR;
        PG8_WAIT_V(2); PG8_BAR;
        PG8_STAGE(PG8_SB(1, 0), cB + kstep, voffB); PG8_STAGE(PG8_SA(1, 0), cA + kstep, voffA); PG8_STAGE(PG8_SB(1, 1), cB + hstep + kstep, voffB);
        PG8_WAIT_V(6); PG8_BAR;
    } else {
        PG8_STAGE(PG8_SB(0, 0), cB, voffB); PG8_STAGE(PG8_SA(0, 0), cA, voffA); PG8_STAGE(PG8_SB(0, 1), cB + hstep, voffB); PG8_STAGE(PG8_SA(0, 1), cA + hstep, voffA);
        if (wr == 1) PG8_BAR;
        PG8_WAIT_V(4); PG8_BAR;
        PG8_STAGE(PG8_SB(1, 0), cB + kstep, voffB); PG8_STAGE(PG8_SA(1, 0), cA + kstep, voffA); PG8_STAGE(PG8_SB(1, 1), cB + hstep + kstep, voffB);
        PG8_WAIT_V(6); PG8_BAR;
    }
    for (;;) {
        const bool has_next = S.next(ui + 1, nxt);
        const char* nA = has_next ? (const char*)g.A + (size_t)nxt.pm * tstep : cA; const char* nB = has_next ? (const char*)g.Bt + (size_t)nxt.pn * tstep : cB;
        for (int t = 0; t < nt; t += 2) {
            const bool last = (t == nt - 2);
            const char* a1 = cA + (size_t)(t + 1) * kstep;
            const char* a2 = last ? nA : cA + (size_t)(t + 2) * kstep; const char* b2 = last ? nB : cB + (size_t)(t + 2) * kstep;
            const char* a3 = a2 + kstep; const char* b3 = b2 + kstep;
            if (last && has_next) S.a_ready(nxt);
            if constexpr (SP2) {
            PG8_LDB(B0, 0, 0); PG8_LDB(B1, 0, 1); PG8_SCHED; PG8_LDA(At, 0, 0); PG8_STAGE(PG8_SA(1, 1), a1 + hstep, voffA);
            PG8_WAIT_V(8); PG8_WAIT_L(0); PG8_BAR; PG8_MMA(0, 0, At, B0); PG8_MMA(0, 1, At, B1); PG8_BAR; PG8_SCHED;
            PG8_LDA(At, 0, 1); PG8_STAGE(PG8_SB(0, 0), b2, voffB); PG8_STAGE(PG8_SB(0, 1), b2 + hstep, voffB); PG8_STAGE(PG8_SA(0, 0), a2, voffA);
            PG8_WAIT_V(8); PG8_WAIT_L(0); PG8_BAR; PG8_MMA(1, 0, At, B0); PG8_MMA(1, 1, At, B1); PG8_BAR; PG8_SCHED;
            PG8_LDB(B0, 1, 0); PG8_LDB(B1, 1, 1); PG8_SCHED; PG8_LDA(At, 1, 0); PG8_STAGE(PG8_SA(0, 1), a2 + hstep, voffA);
            PG8_WAIT_V(8); PG8_WAIT_L(0); PG8_BAR; PG8_MMA(0, 0, At, B0); PG8_MMA(0, 1, At, B1); PG8_BAR; PG8_SCHED;
            PG8_LDA(At, 1, 1); PG8_STAGE(PG8_SB(1, 0), b3, voffB); PG8_STAGE(PG8_SB(1, 1), b3 + hstep, voffB); PG8_STAGE(PG8_SA(1, 0), a3, voffA);
            PG8_WAIT_V(8); PG8_WAIT_L(0); PG8_BAR; PG8_MMA(1, 0, At, B0); PG8_MMA(1, 1, At, B1); PG8_BAR; PG8_SCHED;
            } else {
            PG8_LDB(B0, 0, 0); PG8_SCHED; PG8_LDA(At, 0, 0); PG8_STAGE(PG8_SA(1, 1), a1 + hstep, voffA);
            PG8_WAIT_L(8); PG8_BAR; PG8_WAIT_L(0); PG8_MMA(0, 0, At, B0); PG8_BAR; PG8_SCHED;
            PG8_LDB(B1, 0, 1); PG8_STAGE(PG8_SB(0, 0), b2, voffB);
            PG8_BAR; PG8_WAIT_L(0); PG8_MMA(0, 1, At, B1); PG8_BAR;
            PG8_LDA(At, 0, 1); PG8_STAGE(PG8_SA(0, 0), a2, voffA);
            PG8_BAR; PG8_WAIT_L(0); PG8_MMA(1, 0, At, B0); PG8_BAR; PG8_SCHED;
            PG8_STAGE(PG8_SB(0, 1), b2 + hstep, voffB);
            PG8_WAIT_V(6); PG8_BAR; PG8_MMA(1, 1, At, B1); PG8_BAR;
            PG8_LDB(B0, 1, 0); PG8_SCHED; PG8_LDA(At, 1, 0); PG8_STAGE(PG8_SA(0, 1), a2 + hstep, voffA);
            PG8_WAIT_L(8); PG8_BAR; PG8_WAIT_L(0); PG8_MMA(0, 0, At, B0); PG8_BAR; PG8_SCHED;
            PG8_LDB(B1, 1, 1); PG8_STAGE(PG8_SB(1, 0), b3, voffB);
            PG8_BAR; PG8_WAIT_L(0); PG8_MMA(0, 1, At, B1); PG8_BAR;
            PG8_LDA(At, 1, 1); PG8_STAGE(PG8_SA(1, 0), a3, voffA);
            PG8_BAR; PG8_WAIT_L(0); PG8_MMA(1, 0, At, B0); PG8_BAR; PG8_SCHED;
            PG8_STAGE(PG8_SB(1, 1), b3 + hstep, voffB);
            PG8_WAIT_V(6); PG8_BAR; PG8_MMA(1, 1, At, B1); PG8_BAR;
            }
        }
        if constexpr (ALIGN_EPI) { if (wr == 0) PG8_BAR; }
        if constexpr (!Epi::AFTER_DRAIN) { E(acc, cur, wr, wc, fr, fq); S.done(cur); }
        if (!has_next) break;
#pragma unroll
        for (int a = 0; a < 2; ++a)
#pragma unroll
            for (int b = 0; b < 2; ++b)
#pragma unroll
                for (int m = 0; m < 4; ++m)
#pragma unroll
                    for (int n = 0; n < 2; ++n) acc[a][b][m][n] = (f32x4){0.f, 0.f, 0.f, 0.f};
        cur = nxt; cA = nA; cB = nB; ++ui;
        if constexpr (ALIGN_EPI) { if (wr == 1) PG8_BAR; }
    }
    PG8_WAIT_V(0);
    if constexpr (!ALIGN_EPI) { if (wr == 0) PG8_BAR; }
    PG8_BAR;
    if constexpr (Epi::AFTER_DRAIN) { E.fused(acc, cur, wr, wc, fr, fq, lds, wid, lane); S.done(cur); }
#undef PG8_SA
#undef PG8_SB
#undef PG8_STAGE
#undef PG8_LDA
#undef PG8_LDB
#undef PG8_MMA
#undef PG8_WAIT_V
#undef PG8_WAIT_L
#undef PG8_BAR
#undef PG8_SCHED
}
}

#ifndef MK_ONE_LAUNCH
#define MK_ONE_LAUNCH 1
#endif
typedef unsigned short bf16_t;
typedef short bf16x8 __attribute__((ext_vector_type(8)));
typedef float f32x4 __attribute__((ext_vector_type(4)));
typedef float f32x16 __attribute__((ext_vector_type(16)));
typedef unsigned u32x4 __attribute__((ext_vector_type(4)));
typedef unsigned u32x2 __attribute__((ext_vector_type(2)));

constexpr int NB = 8, SEQ = 8192, MTOK = NB * SEQ, DM = 1024, DFF = 2816, DEPTH = 2;
constexpr int NPROJ = 3840;
constexpr int INW = 3792;
constexpr float RMS_EPS = 1e-6f;
constexpr float LOG2E = 1.4426950408889634f;
constexpr float QSCALE = 0.125f * 1.4426950408889634f;
constexpr float IDX_SCALE = 0.35355339059327373f * 0.125f;
constexpr int AQ_OFF = 0, AK_OFF = 256, AV_OFF = 320, IQ_OFF = 384, IK_OFF = 896, BQ_OFF = 960, BK_OFF = 1216, BV_OFF = 1472,
              CQ_OFF = 1728, CK_OFF = 2240, CV_OFF = 2752, CG_OFF = 3264;
constexpr size_t MiB = 1u << 20;
constexpr size_t WS_CTL = 0, WS_COS = 1 * MiB, WS_SIN = 2 * MiB, WS_IW = 3 * MiB, WS_LF = 5 * MiB, WS_CUM = 7 * MiB, WS_KMEAN = 9 * MiB;
constexpr size_t WS_W = 10 * MiB;
constexpr size_t W_GU_BYTES = (size_t)2 * DFF * DM * 2, W_D_BYTES = (size_t)DM * DFF * 2, W_IN_BYTES = (size_t)NPROJ * DM * 2, W_OUT_BYTES = (size_t)DM * DM * 2;
constexpr size_t WL_GU1 = 0, WL_D1 = WL_GU1 + W_GU_BYTES, WL_GU2 = WL_D1 + W_D_BYTES, WL_D2 = WL_GU2 + W_GU_BYTES, WL_IN = WL_D2 + W_D_BYTES, WL_OUT = WL_IN + W_IN_BYTES,
                 WL_BYTES = WL_OUT + W_OUT_BYTES;
static_assert(WS_W + 2 * WL_BYTES <= 96 * MiB, "weights");
constexpr size_t WS_XN = 96 * MiB, WS_BIG = 224 * MiB, WS_SCR = 704 * MiB, WS_SS = 960 * MiB, WS_END = 984 * MiB;
constexpr size_t WS_HBB = WS_BIG + 352 * MiB;
constexpr size_t SS_STRIDE = (size_t)NB * SEQ * 4;
constexpr int LDS_BYTES = 147456, MISC_OFF = 131072;
constexpr int NTHREADS = 512;

struct Args { const float* in[19]; float* out; unsigned char* ws; int ph_lo, ph_hi; };

__device__ __forceinline__ float bf2f(unsigned short v) { return __uint_as_float((unsigned)v << 16); }
__device__ __forceinline__ unsigned pk2(float lo, float hi) { return pg8::cvt_pk_bf16(lo, hi); }
__device__ __forceinline__ float wave_sum(float v) {
#pragma unroll
    for (int o = 1; o < 64; o <<= 1) v += __shfl_xor(v, o);
    return v;
}
__device__ __forceinline__ float fexp2(float x) { return __builtin_amdgcn_exp2f(x); }
__device__ __forceinline__ float max3f(float a, float b, float c) { float r; asm("v_max3_f32 %0, %1, %2, %3" : "=v"(r) : "v"(a), "v"(b), "v"(c)); return r; }
__device__ __forceinline__ float max2f(float a, float b) { float r; asm("v_max_f32_e32 %0, %1, %2" : "=v"(r) : "v"(a), "v"(b)); return r; }
__device__ __forceinline__ f32x16 mfma32(bf16x8 a, bf16x8 b, f32x16 c) { return __builtin_amdgcn_mfma_f32_32x32x16_bf16(a, b, c, 0, 0, 0); }

__device__ __forceinline__ float row_rscale(const float* SSP, int row) {
    const f32x4* p = (const f32x4*)(SSP + (size_t)row * 16);
    const f32x4 a = p[0], b = p[1], c = p[2], d = p[3];
    const float s = ((a[0] + a[1]) + (a[2] + a[3])) + ((b[0] + b[1]) + (b[2] + b[3])) + ((c[0] + c[1]) + (c[2] + c[3])) + ((d[0] + d[1]) + (d[2] + d[3]));
    return 1.0f / sqrtf(s * (1.0f / DM) + RMS_EPS);
}
struct EpiSwiglu {
    static constexpr bool PERM = true, AFTER_DRAIN = false;
    bf16_t* O; const float* SS;
    __device__ __forceinline__ void operator()(const pg8::f32x4 (&acc)[2][2][4][2], const pg8::Unit& u, int wr, int wc, int fr, int fq) const {
        const int row0 = u.pm * 256 + wr * 64 + fr, col0 = u.pn * 128 + wc * 32 + 8 * fq;
#pragma unroll
        for (int ai = 0; ai < 2; ++ai)
#pragma unroll
            for (int m = 0; m < 4; ++m) {
                float y[8];
                const float rr = row_rscale(SS, row0 + ai * 128 + m * 16);
#pragma unroll
                for (int n = 0; n < 2; ++n)
#pragma unroll
                    for (int i = 0; i < 4; ++i) {
                        const float g = acc[ai][0][m][n][i] * rr, up = acc[ai][1][m][n][i] * rr;
                        const float sg = __builtin_amdgcn_rcpf(1.0f + fexp2(-g * LOG2E));
                        y[4 * n + i] = g * sg * up;
                    }
                u32x4 w; w.x = pk2(y[0], y[1]); w.y = pk2(y[2], y[3]); w.z = pk2(y[4], y[5]); w.w = pk2(y[6], y[7]);
                __builtin_nontemporal_store(w, (u32x4*)(O + (size_t)(row0 + ai * 128 + m * 16) * DFF + col0));
            }
    }
};
template <bool WHB, int ALPHA2>
struct EpiResid {
    static constexpr bool PERM = true, AFTER_DRAIN = false;
    const float* base; float* out; bf16_t* HB; float* SS;
    __device__ __forceinline__ void operator()(const pg8::f32x4 (&acc)[2][2][4][2], const pg8::Unit& u, int wr, int wc, int fr, int fq) const {
        constexpr float alpha = 0.5f * ALPHA2;
        const int row0 = u.pm * 256 + wr * 64 + fr, col0 = u.pn * 256 + wc * 32 + 8 * fq;
#pragma unroll
        for (int ai = 0; ai < 2; ++ai) {
            f32x4 pre[4][2][2];
#pragma unroll
            for (int m = 0; m < 4; ++m)
#pragma unroll
                for (int bj = 0; bj < 2; ++bj) {
                    const size_t ix = (size_t)(row0 + ai * 128 + m * 16) * DM + col0 + bj * 128;
                    pre[m][bj][0] = __builtin_nontemporal_load((const f32x4*)(base + ix)); pre[m][bj][1] = __builtin_nontemporal_load((const f32x4*)(base + ix + 4));
                }
#pragma unroll
            for (int m = 0; m < 4; ++m) {
                const int row = row0 + ai * 128 + m * 16;
                const size_t off = (size_t)row * DM + col0;
                float ssum = 0.f;
#pragma unroll
                for (int bj = 0; bj < 2; ++bj) {
                    const size_t ix = off + bj * 128;
                    const f32x4 b0 = pre[m][bj][0], b1 = pre[m][bj][1];
                    const f32x4 o0 = b0 + acc[ai][bj][m][0] * alpha, o1 = b1 + acc[ai][bj][m][1] * alpha;
                    __builtin_nontemporal_store(o0, (f32x4*)(out + ix)); __builtin_nontemporal_store(o1, (f32x4*)(out + ix + 4));
                    if (WHB) {
                        u32x4 w; w.x = pk2(o0[0], o0[1]); w.y = pk2(o0[2], o0[3]); w.z = pk2(o1[0], o1[1]); w.w = pk2(o1[2], o1[3]);
                        *(u32x4*)(HB + ix) = w;
                        ssum += (o0[0] * o0[0] + o0[1] * o0[1]) + (o0[2] * o0[2] + o0[3] * o0[3]) + (o1[0] * o1[0] + o1[1] * o1[1]) + (o1[2] * o1[2] + o1[3] * o1[3]);
                    }
                }
                if (WHB) {
                    ssum += __shfl_xor(ssum, 16); ssum += __shfl_xor(ssum, 32);
                    if (fq == 0) SS[(size_t)row * 16 + u.pn * 4 + wc] = ssum;
                }
            }
        }
    }
};
struct EpiProj {
    static constexpr bool PERM = true, AFTER_DRAIN = false;
    bf16_t* P; float* IW; float* LF; const float* cosT; const float* sinT;
    const float *gaq, *gak, *gbq, *gbk, *gcq, *gck, *fbias; const float* SS;
    __device__ __forceinline__ void operator()(const pg8::f32x4 (&acc)[2][2][4][2], const pg8::Unit& u, int wr, int wc, int fr, int fq) const {
        const int g = 4 * u.pn + wc;
        const int row0 = u.pm * 256 + wr * 64 + fr;
        if (g == 59) {
            if (fq < 2) {
#pragma unroll
                for (int ai = 0; ai < 2; ++ai)
#pragma unroll
                    for (int m = 0; m < 4; ++m) {
                        const int row = row0 + ai * 128 + m * 16;
                        const float rr = row_rscale(SS, row);
#pragma unroll
                        for (int n = 0; n < 2; ++n) {
                            f32x4 v = acc[ai][0][m][n] * rr;
                            if (fq == 1) {
#pragma unroll
                                for (int i = 0; i < 4; ++i) {
                                    const float x = v[i] + fbias[4 * n + i];
                                    const float ls = (x >= 0.f) ? -log1pf(expf(-x)) : (x - log1pf(expf(x)));
                                    v[i] = ls * LOG2E;
                                }
                                *(f32x4*)(LF + (size_t)row * 8 + 4 * n) = v;
                            } else {
                                *(f32x4*)(IW + (size_t)row * 8 + 4 * n) = v;
                            }
                        }
                    }
            }
            return;
        }
        int mode = 0; const float* gain = gaq;
        if (g < 4) { mode = 1 | 2 | 4; gain = gaq; }
        else if (g == 4) { mode = 1 | 2; gain = gak; }
        else if (g == 5) { mode = 0; }
        else if (g < 15) { mode = 2; }
        else if (g < 19) { mode = 1 | 2 | 4; gain = gbq; }
        else if (g < 23) { mode = 1 | 2; gain = gbk; }
        else if (g < 27) { mode = 0; }
        else if (g < 35) { mode = 1 | 4; gain = gcq; }
        else if (g < 43) { mode = 1; gain = gck; }
        else if (g < 51) { mode = 0; }
        else { mode = 8; }
        f32x4 gn[2][2];
#pragma unroll
        for (int bj = 0; bj < 2; ++bj)
#pragma unroll
            for (int n = 0; n < 2; ++n) gn[bj][n] = (mode & 1) ? *(const f32x4*)(gain + 32 * bj + 8 * fq + 4 * n) : (f32x4){1.f, 1.f, 1.f, 1.f};
        const float qs = (mode & 4) ? QSCALE : 1.0f;
#pragma unroll
        for (int ai = 0; ai < 2; ++ai)
#pragma unroll
            for (int m = 0; m < 4; ++m) {
                const int row = row0 + ai * 128 + m * 16;
                const float rr = row_rscale(SS, row);
                f32x4 v[2][2];
#pragma unroll
                for (int bj = 0; bj < 2; ++bj)
#pragma unroll
                    for (int n = 0; n < 2; ++n) v[bj][n] = acc[ai][bj][m][n] * rr;
                if (mode & 1) {
                    float ss = 0.f;
#pragma unroll
                    for (int bj = 0; bj < 2; ++bj)
#pragma unroll
                        for (int n = 0; n < 2; ++n) ss += (v[bj][n][0] * v[bj][n][0] + v[bj][n][1] * v[bj][n][1]) + (v[bj][n][2] * v[bj][n][2] + v[bj][n][3] * v[bj][n][3]);
                    ss += __shfl_xor(ss, 16); ss += __shfl_xor(ss, 32);
                    const float r = 1.0f / sqrtf(ss * (1.0f / 64.0f) + RMS_EPS);
#pragma unroll
                    for (int bj = 0; bj < 2; ++bj)
#pragma unroll
                        for (int n = 0; n < 2; ++n) v[bj][n] = v[bj][n] * r * gn[bj][n];
                }
                if (mode & 2) {
                    const int pos = row & (SEQ - 1);
#pragma unroll
                    for (int n = 0; n < 2; ++n) {
                        const f32x4 c = *(const f32x4*)(cosT + pos * 32 + 8 * fq + 4 * n), s = *(const f32x4*)(sinT + pos * 32 + 8 * fq + 4 * n);
                        const f32x4 x1 = v[0][n], x2 = v[1][n];
                        v[0][n] = x1 * c - x2 * s; v[1][n] = x2 * c + x1 * s;
                    }
                }
                if (mode & 8) {
#pragma unroll
                    for (int bj = 0; bj < 2; ++bj)
#pragma unroll
                        for (int n = 0; n < 2; ++n)
#pragma unroll
                            for (int i = 0; i < 4; ++i) v[bj][n][i] = 1.0f / (1.0f + __expf(-v[bj][n][i]));
                }
#pragma unroll
                for (int bj = 0; bj < 2; ++bj) {
                    const f32x4 a = v[bj][0] * qs, b = v[bj][1] * qs;
                    u32x4 w; w.x = pk2(a[0], a[1]); w.y = pk2(a[2], a[3]); w.z = pk2(b[0], b[1]); w.w = pk2(b[2], b[3]);
                    __builtin_nontemporal_store(w, (u32x4*)(P + (size_t)row * NPROJ + 64 * g + 32 * bj + 8 * fq));
                }
            }
    }
};

__device__ __forceinline__ int map_row(int kind, int n) {
    if (kind == 0) return n;
    if (kind == 1) return 256 * (n >> 7) + (n & 127);
    if (kind == 2) return 256 * (n >> 7) + 128 + (n & 127);
    int g, d;
    if (n < 384) { g = n >> 6; d = n & 63; }
    else if (n < 960) { g = 6 + ((n - 384) >> 6); d = (n - 384) & 63; }
    else if (n < 968) { g = 59; d = n - 960; }
    else if (n < 3272) { g = 15 + ((n - 968) >> 6); d = (n - 968) & 63; }
    else if (n < 3280) { g = 59; d = 8 + (n - 3272); }
    else { g = 51 + ((n - 3280) >> 6); d = (n - 3280) & 63; }
    return 256 * (g >> 2) + 128 * (d >> 5) + 32 * (g & 3) + (d & 31);
}
__device__ __forceinline__ void transpose_item(const float* W, const float* gain, int K, int N, bf16_t* WT, int kind, float* scr, int item, int lane) {
    const int nblk = (N + 31) / 32, kb = item / nblk, nb = item % nblk, k0 = 64 * kb, n0 = 32 * nb;
    const int n4 = 4 * (lane & 7), nc = n0 + n4;
#pragma unroll
    for (int i = 0; i < 8; ++i) {
        const int kk = 8 * i + (lane >> 3);
        f32x4 v = (nc < N) ? *(const f32x4*)(W + (size_t)(k0 + kk) * N + nc) : (f32x4){0.f, 0.f, 0.f, 0.f};
        if (gain) v = v * gain[k0 + kk];
        scr[kk * 33 + n4] = v[0]; scr[kk * 33 + n4 + 1] = v[1]; scr[kk * 33 + n4 + 2] = v[2]; scr[kk * 33 + n4 + 3] = v[3];
    }
    __builtin_amdgcn_fence(__ATOMIC_RELEASE, "wavefront"); __builtin_amdgcn_wave_barrier(); __builtin_amdgcn_fence(__ATOMIC_ACQUIRE, "wavefront");
    const int c = lane & 7;
#pragma unroll
    for (int j = 0; j < 4; ++j) {
        const int n = (lane >> 3) + 8 * j; const float* s = scr + (8 * c) * 33 + n;
        u32x4 o; o.x = pk2(s[0 * 33], s[1 * 33]); o.y = pk2(s[2 * 33], s[3 * 33]); o.z = pk2(s[4 * 33], s[5 * 33]); o.w = pk2(s[6 * 33], s[7 * 33]);
        if (n0 + n < N) *(u32x4*)(WT + (size_t)map_row(kind, n0 + n) * K + k0 + 8 * c) = o;
    }
    __builtin_amdgcn_fence(__ATOMIC_RELEASE, "wavefront"); __builtin_amdgcn_wave_barrier(); __builtin_amdgcn_fence(__ATOMIC_ACQUIRE, "wavefront");
}
__device__ __forceinline__ void cvt_row(const float* xrow, bf16_t* orow, float* ss, int lane) {
    const f32x4* xr = (const f32x4*)xrow + lane;
    f32x4 v[4]; float s = 0.f;
#pragma unroll
    for (int j = 0; j < 4; ++j) { v[j] = xr[64 * j]; s += (v[j][0] * v[j][0] + v[j][1] * v[j][1]) + (v[j][2] * v[j][2] + v[j][3] * v[j][3]); }
    s = wave_sum(s);
    u32x2* o8 = (u32x2*)orow + lane;
#pragma unroll
    for (int j = 0; j < 4; ++j) { u32x2 w; w.x = pk2(v[j][0], v[j][1]); w.y = pk2(v[j][2], v[j][3]); o8[64 * j] = w; }
    if (lane < 16) ss[lane] = (lane == 0) ? s : 0.f;
}

__device__ __forceinline__ void scan_kmean_phase(const float* LF, float* CUM, const bf16_t* P, float* KMEAN, char* lds) {
    const int tid = threadIdx.x, lane = tid & 63, wave = tid >> 6;
    double* sd = (double*)lds;
    for (int u = blockIdx.x; u < 64; u += gridDim.x) {
        const int b = u >> 3, hh = u & 7;
        const float* src = LF + ((size_t)b * SEQ + 16 * tid) * 8 + hh;
        double loc[16]; double run = 0.0;
#pragma unroll
        for (int e = 0; e < 16; ++e) { run += (double)src[e * 8]; loc[e] = run; }
        __syncthreads();
        sd[tid] = run;
        __syncthreads();
        for (int off = 1; off < 512; off <<= 1) {
            const double v = (tid >= off) ? sd[tid - off] : 0.0;
            __syncthreads();
            sd[tid] += v;
            __syncthreads();
        }
        const double base = (tid > 0) ? sd[tid - 1] : 0.0;
        float* dst = CUM + ((size_t)b * SEQ + 16 * tid) * 8 + hh;
#pragma unroll
        for (int e = 0; e < 16; ++e) dst[e * 8] = (float)(base + loc[e]);
        __syncthreads();
    }
    const bool split = gridDim.x >= 128;
    if (split && blockIdx.x < 64) return;
    const int gw = (split ? (int)blockIdx.x - 64 : (int)blockIdx.x) * 8 + wave, ngw = (split ? (int)gridDim.x - 64 : (int)gridDim.x) * 8;
    for (int u = gw; u < NB * 4 * 32; u += ngw) {
        const int b = u >> 7, h = (u >> 5) & 3, blk = u & 31;
        const bf16_t* src = P + ((size_t)b * SEQ + 256 * blk + (lane >> 3)) * NPROJ + BK_OFF + 64 * h + 8 * (lane & 7);
        float acc[8];
#pragma unroll
        for (int e = 0; e < 8; ++e) acc[e] = 0.f;
#pragma unroll 8
        for (int i = 0; i < 32; ++i) {
            const u32x4 v = *(const u32x4*)(src + (size_t)(8 * i) * NPROJ);
            acc[0] += __uint_as_float(v.x << 16); acc[1] += __uint_as_float(v.x & 0xffff0000u);
            acc[2] += __uint_as_float(v.y << 16); acc[3] += __uint_as_float(v.y & 0xffff0000u);
            acc[4] += __uint_as_float(v.z << 16); acc[5] += __uint_as_float(v.z & 0xffff0000u);
            acc[6] += __uint_as_float(v.w << 16); acc[7] += __uint_as_float(v.w & 0xffff0000u);
        }
#pragma unroll
        for (int e = 0; e < 8; ++e) { acc[e] += __shfl_xor(acc[e], 8); acc[e] += __shfl_xor(acc[e], 16); acc[e] += __shfl_xor(acc[e], 32); }
        if (lane < 8) {
            f32x4 o0v, o1v;
            o0v[0] = acc[0] * (1.0f / 256.0f); o0v[1] = acc[1] * (1.0f / 256.0f); o0v[2] = acc[2] * (1.0f / 256.0f); o0v[3] = acc[3] * (1.0f / 256.0f);
            o1v[0] = acc[4] * (1.0f / 256.0f); o1v[1] = acc[5] * (1.0f / 256.0f); o1v[2] = acc[6] * (1.0f / 256.0f); o1v[3] = acc[7] * (1.0f / 256.0f);
            *(f32x4*)(KMEAN + (size_t)u * 64 + 8 * lane) = o0v; *(f32x4*)(KMEAN + (size_t)u * 64 + 8 * lane + 4) = o1v;
        }
    }
}

constexpr int KS_LD = 72, VT_LD = 68;
constexpr int FL_KS = 0, FL_VT = FL_KS + 64 * KS_LD * 2, FL_CK = FL_VT + 64 * VT_LD * 2, FL_BUF = FL_CK + 256, FL_END = 2 * FL_BUF;
template <int MODE>
__device__ __forceinline__ void flash_unit(const bf16_t* __restrict__ P, const float* __restrict__ CUM, const float* __restrict__ KMEAN, bf16_t* __restrict__ MIX,
                                           const float* __restrict__ gq, const float* __restrict__ gk, int b, int h, int qt, char* lds) {
    int tid_ = threadIdx.x; asm volatile("" : "+v"(tid_));
    const int tid = tid_, lane = tid & 63, w = __builtin_amdgcn_readfirstlane(tid >> 6), l32 = lane & 31, hi = lane >> 5;
    constexpr int QOFF = MODE == 0 ? CQ_OFF : BQ_OFF, KOFF = MODE == 0 ? CK_OFF : BK_OFF, VOFF = MODE == 0 ? CV_OFF : BV_OFF, OOFF = MODE == 0 ? 512 : 256;
    unsigned* umask = (unsigned*)(lds + FL_END);
    const size_t rowbase = (size_t)b * SEQ;
    const int q0 = qt * 256 + w * 32, myq = q0 + l32;
    const bf16_t* qrow = P + (rowbase + myq) * NPROJ + QOFF + 64 * h;
    bf16x8 qf[4];
#pragma unroll
    for (int ks = 0; ks < 4; ++ks) qf[ks] = *(const bf16x8*)(qrow + 16 * ks + 8 * hi);
    unsigned selmask = 0, unionmask = 0xffffffffu;
    if (MODE == 1) {
        float v1 = -INFINITY, v2 = -INFINITY, v3 = -INFINITY; int i1 = -1, i2 = -1, i3 = -1;
        const float* km = KMEAN + ((size_t)(b * 4 + h) * 32) * 64;
        for (int n = 0; n < qt; ++n) {
            float gsum = 0.f;
#pragma unroll
            for (int c8 = 0; c8 < 8; ++c8) {
                const u32x4 qv = *(const u32x4*)(qrow + 8 * c8);
                const f32x4 k0 = *(const f32x4*)(km + n * 64 + 8 * c8), k1 = *(const f32x4*)(km + n * 64 + 8 * c8 + 4);
                gsum += __uint_as_float(qv.x << 16) * k0[0] + __uint_as_float(qv.x & 0xffff0000u) * k0[1] + __uint_as_float(qv.y << 16) * k0[2] + __uint_as_float(qv.y & 0xffff0000u) * k0[3]
                      + __uint_as_float(qv.z << 16) * k1[0] + __uint_as_float(qv.z & 0xffff0000u) * k1[1] + __uint_as_float(qv.w << 16) * k1[2] + __uint_as_float(qv.w & 0xffff0000u) * k1[3];
            }
            if (gsum > v3) {
                if (gsum > v1) { v3 = v2; i3 = i2; v2 = v1; i2 = i1; v1 = gsum; i1 = n; }
                else if (gsum > v2) { v3 = v2; i3 = i2; v2 = gsum; i2 = n; }
                else { v3 = gsum; i3 = n; }
            }
        }
        if (i1 >= 0) selmask |= 1u << i1;
        if (i2 >= 0) selmask |= 1u << i2;
        if (i3 >= 0) selmask |= 1u << i3;
        __syncthreads();
        if (tid == 0) *umask = 0u;
        __syncthreads();
        unsigned wm = selmask;
#pragma unroll
        for (int o = 1; o < 64; o <<= 1) wm |= __shfl_xor(wm, o);
        if (lane == 0) atomicOr(umask, wm);
        __syncthreads();
        unionmask = *umask;
    }
    float cref = 0.f;
    if (MODE == 0) cref = CUM[(rowbase + qt * 256) * 8 + h];
    float m = -INFINITY, lsum = 0.f;
    f32x16 o0, o1;
#pragma unroll
    for (int r = 0; r < 16; ++r) { o0[r] = 0.f; o1[r] = 0.f; }
    const int NT = 4 * qt + 4;
    const int kkey = tid >> 3, kch = tid & 7;
    const int vkey = 16 * (w & 3) + (lane & 15), vch = 4 * (w >> 2) + (lane >> 4);
    int kt = 0;
    if (MODE == 1) { while (kt < 4 * qt && !((unionmask >> (kt >> 2)) & 1u)) ++kt; }
    if (MODE == 0) {
        float gqm = fabsf(gq[lane]), gkm = fabsf(gk[lane]);
#pragma unroll
        for (int o = 1; o < 64; o <<= 1) { gqm = fmaxf(gqm, __shfl_xor(gqm, o)); gkm = fmaxf(gkm, __shfl_xor(gkm, o)); }
        const float margin = 2.0f * (64.0f * gqm * gkm * QSCALE * 1.02f) + 40.0f;
        bool skip = false;
        if (tid < 4 * qt) skip = (cref - CUM[(rowbase + 64 * tid + 63) * 8 + h]) < -margin;
        kt = __syncthreads_count(skip ? 1 : 0);
    }
    u32x4 kreg, vreg; float creg = 0.f;
#define FL_LOAD(kt_) do { kreg = *(const u32x4*)(P + (rowbase + 64 * (kt_) + kkey) * NPROJ + KOFF + 64 * h + 8 * kch); \
        vreg = *(const u32x4*)(P + (rowbase + 64 * (kt_) + vkey) * NPROJ + VOFF + 64 * h + 8 * vch); \
        if (MODE == 0 && tid < 64) creg = cref - CUM[(rowbase + 64 * (kt_) + tid) * 8 + h]; } while (0)
#define FL_STORE(buf_) do { bf16_t* Kd_ = (bf16_t*)(lds + (buf_) * FL_BUF + FL_KS); bf16_t* Vd_ = (bf16_t*)(lds + (buf_) * FL_BUF + FL_VT); \
        *(u32x4*)(Kd_ + kkey * KS_LD + 8 * kch) = kreg; \
        bf16_t* vd = Vd_ + (8 * vch) * VT_LD + vkey; \
        vd[0 * VT_LD] = (bf16_t)(vreg.x & 0xffffu); vd[1 * VT_LD] = (bf16_t)(vreg.x >> 16); \
        vd[2 * VT_LD] = (bf16_t)(vreg.y & 0xffffu); vd[3 * VT_LD] = (bf16_t)(vreg.y >> 16); \
        vd[4 * VT_LD] = (bf16_t)(vreg.z & 0xffffu); vd[5 * VT_LD] = (bf16_t)(vreg.z >> 16); \
        vd[6 * VT_LD] = (bf16_t)(vreg.w & 0xffffu); vd[7 * VT_LD] = (bf16_t)(vreg.w >> 16); \
        if (MODE == 0 && tid < 64) ((float*)(lds + (buf_) * FL_BUF + FL_CK))[tid] = creg; } while (0)
    FL_LOAD(kt);
    __syncthreads();
    FL_STORE(0);
    __syncthreads();
    int cur = 0;
    while (kt < NT) {
        const int ktc = kt;
        int ktn = kt + 1;
        if (MODE == 1) { while (ktn < 4 * qt && !((unionmask >> (ktn >> 2)) & 1u)) ++ktn; }
        if (ktn < NT) FL_LOAD(ktn);
        kt = ktn;
        const bf16_t* Ks = (const bf16_t*)(lds + cur * FL_BUF + FL_KS); const bf16_t* VT = (const bf16_t*)(lds + cur * FL_BUF + FL_VT);
        const float* cks = (const float*)(lds + cur * FL_BUF + FL_CK);
        if (!(64 * ktc > q0 + 31)) {
        f32x16 s0, s1;
#pragma unroll
        for (int r = 0; r < 16; ++r) { s0[r] = 0.f; s1[r] = 0.f; }
#pragma unroll
        for (int ks = 0; ks < 4; ++ks) {
            const bf16x8 a0 = *(const bf16x8*)(Ks + l32 * KS_LD + 16 * ks + 8 * hi);
            const bf16x8 a1 = *(const bf16x8*)(Ks + (32 + l32) * KS_LD + 16 * ks + 8 * hi);
            s0 = mfma32(a0, qf[ks], s0); s1 = mfma32(a1, qf[ks], s1);
        }
        if (MODE == 0) {
#pragma unroll
            for (int g = 0; g < 4; ++g) {
                const f32x4 c0 = *(const f32x4*)(cks + 8 * g + 4 * hi), c1 = *(const f32x4*)(cks + 32 + 8 * g + 4 * hi);
#pragma unroll
                for (int i = 0; i < 4; ++i) { s0[4 * g + i] += c0[i]; s1[4 * g + i] += c1[i]; }
            }
        }
        if (MODE == 1 && ktc < 4 * qt) {
            if (!((selmask >> (ktc >> 2)) & 1u)) {
#pragma unroll
                for (int r = 0; r < 16; ++r) { s0[r] = -INFINITY; s1[r] = -INFINITY; }
            }
        }
        if (64 * ktc + 63 > q0) {
#pragma unroll
            for (int r = 0; r < 16; ++r) {
                const int kg = 64 * ktc + 8 * (r >> 2) + 4 * hi + (r & 3);
                if (kg > myq) s0[r] = -INFINITY;
                if (kg + 32 > myq) s1[r] = -INFINITY;
            }
        }
        float mxa = max3f(s0[0], s0[1], s0[2]), mxb = max3f(s1[0], s1[1], s1[2]);
#pragma unroll
        for (int r = 3; r < 15; r += 2) { mxa = max3f(mxa, s0[r], s0[r + 1]); mxb = max3f(mxb, s1[r], s1[r + 1]); }
        float mx = max3f(mxa, mxb, s0[15]); mx = max2f(mx, s1[15]);
        mx = max2f(mx, __shfl_xor(mx, 32));
        const float mnew = max2f(m, mx);
        const float msafe = (mnew == -INFINITY) ? 0.f : mnew;
        const float alpha = fexp2(m - msafe);
        float psum = 0.f;
#pragma unroll
        for (int r = 0; r < 16; ++r) { s0[r] = fexp2(s0[r] - msafe); s1[r] = fexp2(s1[r] - msafe); psum += s0[r] + s1[r]; }
        lsum = lsum * alpha + psum; m = mnew;
#pragma unroll
        for (int r = 0; r < 16; ++r) { o0[r] *= alpha; o1[r] *= alpha; }
        bf16x8 pk[4];
        {
            u32x4 t;
            t.x = pk2(s0[0], s0[1]); t.y = pk2(s0[2], s0[3]); t.z = pk2(s0[4], s0[5]); t.w = pk2(s0[6], s0[7]); pk[0] = __builtin_bit_cast(bf16x8, t);
            t.x = pk2(s0[8], s0[9]); t.y = pk2(s0[10], s0[11]); t.z = pk2(s0[12], s0[13]); t.w = pk2(s0[14], s0[15]); pk[1] = __builtin_bit_cast(bf16x8, t);
            t.x = pk2(s1[0], s1[1]); t.y = pk2(s1[2], s1[3]); t.z = pk2(s1[4], s1[5]); t.w = pk2(s1[6], s1[7]); pk[2] = __builtin_bit_cast(bf16x8, t);
            t.x = pk2(s1[8], s1[9]); t.y = pk2(s1[10], s1[11]); t.z = pk2(s1[12], s1[13]); t.w = pk2(s1[14], s1[15]); pk[3] = __builtin_bit_cast(bf16x8, t);
        }
#pragma unroll
        for (int kk = 0; kk < 4; ++kk) {
            u32x4 a, c;
            const u32x2 a_lo = *(const u32x2*)(VT + l32 * VT_LD + 16 * kk + 4 * hi), a_hi = *(const u32x2*)(VT + l32 * VT_LD + 16 * kk + 8 + 4 * hi);
            const u32x2 c_lo = *(const u32x2*)(VT + (32 + l32) * VT_LD + 16 * kk + 4 * hi), c_hi = *(const u32x2*)(VT + (32 + l32) * VT_LD + 16 * kk + 8 + 4 * hi);
            a.x = a_lo.x; a.y = a_lo.y; a.z = a_hi.x; a.w = a_hi.y; c.x = c_lo.x; c.y = c_lo.y; c.z = c_hi.x; c.w = c_hi.y;
            o0 = mfma32(__builtin_bit_cast(bf16x8, a), pk[kk], o0);
            o1 = mfma32(__builtin_bit_cast(bf16x8, c), pk[kk], o1);
        }
        }
        if (kt < NT) FL_STORE(cur ^ 1);
        __syncthreads();
        cur ^= 1;
    }
#undef FL_LOAD
#undef FL_STORE
    const float ltot = lsum + __shfl_xor(lsum, 32);
    const float inv = 1.0f / ltot;
    bf16_t* orow = MIX + (rowbase + myq) * DM + OOFF + 64 * h;
    const bf16_t* grow = P + (rowbase + myq) * NPROJ + CG_OFF + 64 * h;
#pragma unroll
    for (int g = 0; g < 4; ++g) {
        const int d = 8 * g + 4 * hi;
        float a0 = o0[4 * g] * inv, a1 = o0[4 * g + 1] * inv, a2 = o0[4 * g + 2] * inv, a3 = o0[4 * g + 3] * inv;
        float c0 = o1[4 * g] * inv, c1 = o1[4 * g + 1] * inv, c2 = o1[4 * g + 2] * inv, c3 = o1[4 * g + 3] * inv;
        if (MODE == 0) {
            const u32x2 ga = *(const u32x2*)(grow + d), gc = *(const u32x2*)(grow + 32 + d);
            a0 *= __uint_as_float(ga.x << 16); a1 *= __uint_as_float(ga.x & 0xffff0000u); a2 *= __uint_as_float(ga.y << 16); a3 *= __uint_as_float(ga.y & 0xffff0000u);
            c0 *= __uint_as_float(gc.x << 16); c1 *= __uint_as_float(gc.x & 0xffff0000u); c2 *= __uint_as_float(gc.y << 16); c3 *= __uint_as_float(gc.y & 0xffff0000u);
        }
        u32x2 wa, wc2; wa.x = pk2(a0, a1); wa.y = pk2(a2, a3); wc2.x = pk2(c0, c1); wc2.y = pk2(c2, c3);
        *(u32x2*)(orow + d) = wa; *(u32x2*)(orow + 32 + d) = wc2;
    }
    __syncthreads();
}

constexpr int KI_LD = 72;
constexpr int VTD_LD = 72, PW_LD = 256;
constexpr int SEL_CAP = 512, CMP_CAP = 768;
constexpr int DS_KI = 0, DS_VT = 0, DS_LIST = 8 * 64 * VTD_LD * 2, DS_PW = DS_LIST + 8 * 512, DS_CK = DS_PW + 8 * 4 * PW_LD * 2, DS_CI = DS_CK + 8 * CMP_CAP * 4, DS_END = DS_CI + 8 * CMP_CAP * 2;
static_assert(512 * KI_LD * 2 <= DS_LIST && DS_END <= 131072, "DSA LDS map");
typedef short v4i16_t __attribute__((ext_vector_type(4)));
__device__ __forceinline__ v4i16_t ds_tr16(const void* p) { return __builtin_amdgcn_ds_read_tr16_b64_v4i16((__attribute__((address_space(3))) v4i16_t*)p); }
__device__ __forceinline__ void dsa_unit(const bf16_t* __restrict__ P, const float* __restrict__ IW, bf16_t* __restrict__ MIX, float* __restrict__ scr, int b, int tile, char* lds) {
    int tid_ = threadIdx.x; asm volatile("" : "+v"(tid_));
    const int tid = tid_, lane = tid & 63, w = __builtin_amdgcn_readfirstlane(tid >> 6), l32 = lane & 31, hi = lane >> 5;
    bf16_t* KI = (bf16_t*)(lds + DS_KI);
    unsigned short* LIST = (unsigned short*)(lds + DS_LIST) + w * 256;
    bf16_t* PWb = (bf16_t*)(lds + DS_PW) + w * 4 * PW_LD;
    bf16_t* Vt = (bf16_t*)(lds + DS_VT) + w * 64 * VTD_LD;
    unsigned* CK = (unsigned*)(lds + DS_CK) + w * CMP_CAP; unsigned short* CI = (unsigned short*)(lds + DS_CI) + w * CMP_CAP;
    const size_t rowbase = (size_t)b * SEQ;
    const int t0 = 32 * tile;
#ifdef PROBE_SCORE2
#pragma unroll 1
    for (int rep_ = 0; rep_ < 2; ++rep_)
#endif
    {
        const int qsel = ((l32 >> 4) & 1) + 2 * ((l32 >> 2) & 1), head = (l32 & 3) + 4 * ((l32 >> 3) & 1);
        const bf16_t* arow = P + (rowbase + t0 + 4 * w + qsel) * NPROJ + IQ_OFF + 64 * head + 8 * hi;
        bf16x8 af[4];
#pragma unroll
        for (int ks = 0; ks < 4; ++ks) af[ks] = *(const bf16x8*)(arow + 16 * ks);
        float wA[8], wB[8];
        {
            const float* wa = IW + (rowbase + t0 + 4 * w + 2 * hi) * 8;
#pragma unroll
            for (int hh = 0; hh < 8; ++hh) { wA[hh] = wa[hh] * IDX_SCALE; wB[hh] = wa[8 + hh] * IDX_SCALE; }
        }
        const int nkt = tile + 1, nchunk = (nkt + 15) >> 4;
        float* sA = scr + (size_t)(4 * w + 2 * hi) * SEQ; float* sB = sA + SEQ;
        u32x4 stg[8];
        const bf16_t* kisrc = P + (rowbase + (tid >> 3)) * NPROJ + IK_OFF + 8 * (tid & 7);
#pragma unroll
        for (int i8 = 0; i8 < 8; ++i8) stg[i8] = *(const u32x4*)(kisrc + (size_t)(64 * i8) * NPROJ);
#pragma unroll 1
        for (int c = 0; c < nchunk; ++c) {
            __syncthreads();
#pragma unroll
            for (int i8 = 0; i8 < 8; ++i8) *(u32x4*)(KI + ((tid >> 3) + 64 * i8) * KI_LD + 8 * (tid & 7)) = stg[i8];
            __syncthreads();
            if (c + 1 < nchunk) {
#pragma unroll
                for (int i8 = 0; i8 < 8; ++i8) stg[i8] = *(const u32x4*)(kisrc + (size_t)(512 * (c + 1) + 64 * i8) * NPROJ);
            }
            const int ntl = (nkt - 16 * c) < 16 ? (nkt - 16 * c) : 16;
#define SCORE_MMA(D_, k8_) do { _Pragma("unroll") for (int r_ = 0; r_ < 16; ++r_) D_[r_] = 0.f; \
                _Pragma("unroll") for (int ks_ = 0; ks_ < 4; ++ks_) D_ = mfma32(af[ks_], *(const bf16x8*)(KI + (32 * (k8_) + l32) * KI_LD + 16 * ks_ + 8 * hi), D_); } while (0)
#define SCORE_OUT(D_, k8_) do { float a_ = 0.f, b_ = 0.f; \
                _Pragma("unroll") for (int hh_ = 0; hh_ < 8; ++hh_) { a_ = __builtin_fmaf(wA[hh_], __builtin_amdgcn_fmed3f(D_[hh_], 0.f, __builtin_inff()), a_); \
                                                                     b_ = __builtin_fmaf(wB[hh_], __builtin_amdgcn_fmed3f(D_[8 + hh_], 0.f, __builtin_inff()), b_); } \
                const int key_ = 512 * c + 32 * (k8_) + l32; \
                const int ba_ = (int)__float_as_uint(a_ + 0.0f), bb_ = (int)__float_as_uint(b_ + 0.0f); \
                __builtin_nontemporal_store(__uint_as_float((unsigned)ba_ ^ ((unsigned)(ba_ >> 31) | 0x80000000u)), sA + key_); \
                __builtin_nontemporal_store(__uint_as_float((unsigned)bb_ ^ ((unsigned)(bb_ >> 31) | 0x80000000u)), sB + key_); } while (0)
            int k8 = 0;
#pragma unroll 1
            for (; k8 + 3 < ntl; k8 += 4) {
                f32x16 D0, D1, D2, D3;
                SCORE_MMA(D0, k8); SCORE_MMA(D1, k8 + 1); SCORE_MMA(D2, k8 + 2); SCORE_MMA(D3, k8 + 3);
                SCORE_OUT(D0, k8); SCORE_OUT(D1, k8 + 1); SCORE_OUT(D2, k8 + 2); SCORE_OUT(D3, k8 + 3);
            }
#pragma unroll 1
            for (; k8 < ntl; ++k8) { f32x16 D0; SCORE_MMA(D0, k8); SCORE_OUT(D0, k8); }
#undef SCORE_MMA
#undef SCORE_OUT
        }
    }
    __syncthreads();
    __builtin_amdgcn_fence(__ATOMIC_ACQUIRE, "agent");
    int eg = 127;
#pragma unroll 1
    for (int qq = 0; qq < 4; ++qq) {
        const int t = t0 + 4 * w + qq, n = t + 1;
        const size_t row = rowbase + t;
        int lane = threadIdx.x & 63; asm volatile("" : "+v"(lane));
        const float* srow = scr + (size_t)(4 * w + qq) * SEQ + lane;
        asm volatile("" : "+v"(srow));
        int cnt;
        if (n <= 256) {
            cnt = n;
            for (int j = lane; j < n; j += 64) LIST[j] = (unsigned short)j;
        } else {
            cnt = 256;
            unsigned v[128];
#pragma unroll
            for (int g = 0; g < 8; ++g) {
                if ((g + 1) * 1024 <= n) {
#pragma unroll
                    for (int jj = 0; jj < 16; ++jj) v[g * 16 + jj] = __float_as_uint(__builtin_nontemporal_load(srow + (g * 16 + jj) * 64));
                    asm volatile("" ::: "memory");
                } else if (g * 1024 < n) {
                    int lb = lane; asm volatile("" : "+v"(lb));
#pragma unroll
                    for (int jj = 0; jj < 16; ++jj) {
                        const int idx = (g * 16 + jj) * 64 + lb;
                        v[g * 16 + jj] = (idx < n) ? __float_as_uint(__builtin_nontemporal_load(srow + (g * 16 + jj) * 64)) : 0u;
                    }
                    asm volatile("" ::: "memory");
                } else {
#pragma unroll
                    for (int jj = 0; jj < 16; ++jj) v[g * 16 + jj] = 0u;
                }
            }
            unsigned T = 0u; int cT = n, cU = 0; int bit = 31; bool exact = false;
            if (n > 1024) {
                unsigned probe = 0x80000000u | ((unsigned)eg << 23);
                int cp = 0;
#pragma unroll
                for (int g = 0; g < 8; ++g) {
                    if (g * 1024 < n) {
#pragma unroll
                        for (int jj = 0; jj < 16; ++jj) cp += __builtin_popcountll(__ballot(v[g * 16 + jj] >= probe));
                    }
                }
                const bool up = cp >= 256;
#pragma unroll 1
                for (int tr = 0; tr < 3; ++tr) {
                    const unsigned p2 = up ? probe + (1u << 23) : probe - (1u << 23);
                    int c2 = 0;
#pragma unroll
                    for (int g = 0; g < 8; ++g) {
                        if (g * 1024 < n) {
#pragma unroll
                            for (int jj = 0; jj < 16; ++jj) c2 += __builtin_popcountll(__ballot(v[g * 16 + jj] >= p2));
                        }
                    }
                    if (up ? (c2 < 256) : (c2 >= 256)) {
                        T = up ? probe : p2; cT = up ? cp : c2; cU = up ? c2 : cp; bit = 22;
                        if (cT == 256) exact = true;
                        break;
                    }
                    probe = p2; cp = c2;
                }
            }
#pragma unroll 1
            while (!exact && bit >= 0 && (cT - cU) > SEL_CAP) {
                const unsigned cand = T | (1u << bit);
                int c = 0;
#pragma unroll
                for (int g = 0; g < 8; ++g) {
                    if (g * 1024 < n) {
#pragma unroll
                        for (int jj = 0; jj < 16; ++jj) c += __builtin_popcountll(__ballot(v[g * 16 + jj] >= cand));
                    }
                }
                --bit;
                if (c >= 256) { T = cand; cT = c; if (c == 256) { exact = true; break; } }
                else { cU = c; }
            }
            if (exact) {
                int pos = 0;
#pragma unroll
                for (int g = 0; g < 8; ++g) {
                    if (g * 1024 < n) {
                        int lb = lane; asm volatile("" : "+v"(lb));
#pragma unroll
                        for (int jj = 0; jj < 16; ++jj) {
                            const unsigned x = v[g * 16 + jj]; const int idx = (g * 16 + jj) * 64 + lb;
                            const bool gt = x >= T; const unsigned long long mg = __ballot(gt);
                            const int pre = __builtin_amdgcn_mbcnt_hi((unsigned)(mg >> 32), __builtin_amdgcn_mbcnt_lo((unsigned)mg, 0u));
                            if (gt) LIST[pos + pre] = (unsigned short)idx;
                            pos += __builtin_popcountll(mg);
                        }
                    }
                }
            } else {
                int bpos = 0;
                const unsigned Tb = T ? T : 1u;
#pragma unroll
                for (int g = 0; g < 8; ++g) {
                    if (g * 1024 < n) {
                        int lb = lane; asm volatile("" : "+v"(lb));
#pragma unroll
                        for (int jj = 0; jj < 16; ++jj) {
                            const unsigned x = v[g * 16 + jj]; const int idx = (g * 16 + jj) * 64 + lb;
                            const bool inb = (x >= Tb); const unsigned long long mb = __ballot(inb);
                            const int pb = __builtin_amdgcn_mbcnt_hi((unsigned)(mb >> 32), __builtin_amdgcn_mbcnt_lo((unsigned)mb, 0u));
                            if (inb && (bpos + pb) < CMP_CAP) { CK[bpos + pb] = x; CI[bpos + pb] = (unsigned short)idx; }
                            bpos += __builtin_popcountll(mb);
                        }
                    }
                }
                asm volatile("s_waitcnt lgkmcnt(0)" ::: "memory");
                __builtin_amdgcn_wave_barrier();
                const int mall = cT < CMP_CAP ? cT : CMP_CAP;
                unsigned cv[CMP_CAP / 64];
#pragma unroll
                for (int e = 0; e < CMP_CAP / 64; ++e) { const int p = e * 64 + lane; cv[e] = (p < mall) ? CK[p] : 0u; }
                bool exact2 = false;
#pragma unroll 1
                for (; bit >= 0; --bit) {
                    const unsigned cand = T | (1u << bit);
                    int c = 0;
#pragma unroll
                    for (int e = 0; e < CMP_CAP / 64; ++e) c += __builtin_popcountll(__ballot(cv[e] >= cand));
                    if (c >= 256) { T = cand; if (c == 256) { exact2 = true; break; } }
                }
                const unsigned Tg = exact2 ? (T - 1u) : T;
                int Gb = 0;
#pragma unroll
                for (int e = 0; e < CMP_CAP / 64; ++e) Gb += __builtin_popcountll(__ballot(cv[e] > Tg));
                const int E = exact2 ? 0 : (256 - Gb);
                int gpos = 0, eqseen = 0;
#pragma unroll
                for (int e = 0; e < CMP_CAP / 64; ++e) {
                    const int p = e * 64 + lane; const unsigned x = cv[e];
                    const unsigned short ci = CI[p < mall ? p : 0];
                    const bool gt = x > Tg; const unsigned long long mg = __ballot(gt);
                    const int pre = __builtin_amdgcn_mbcnt_hi((unsigned)(mg >> 32), __builtin_amdgcn_mbcnt_lo((unsigned)mg, 0u));
                    if (gt) LIST[gpos + pre] = ci;
                    gpos += __builtin_popcountll(mg);
                    const bool eq = (!exact2) && (x == T) && (p < mall); const unsigned long long me = __ballot(eq);
                    const int pe = __builtin_amdgcn_mbcnt_hi((unsigned)(me >> 32), __builtin_amdgcn_mbcnt_lo((unsigned)me, 0u));
                    if (eq && (eqseen + pe) < E) LIST[Gb + eqseen + pe] = ci;
                    eqseen += __builtin_popcountll(me);
                }
            }
            if (T >= 0x80800000u) { const int e_ = (int)((T >> 23) & 0xffu); eg = e_ < 4 ? 4 : (e_ > 250 ? 250 : e_); }
        }
        __builtin_amdgcn_fence(__ATOMIC_RELEASE, "wavefront"); __builtin_amdgcn_wave_barrier(); __builtin_amdgcn_fence(__ATOMIC_ACQUIRE, "wavefront");
#ifdef PROBE_ATTN2
#pragma unroll 1
        for (int rep_ = 0; rep_ < 2; ++rep_) {
#else
        {
#endif
        int ln = lane; asm volatile("" : "+v"(ln));
        const int l32a = ln & 31, hia = ln >> 5;
        bf16x8 aq[4];
        {
            const bf16_t* qr = P + row * NPROJ + AQ_OFF + 64 * (l32a & 3) + 8 * hia;
#pragma unroll
            for (int ks = 0; ks < 4; ++ks) {
                bf16x8 z = *(const bf16x8*)(qr + 16 * ks);
                if (l32a >= 4) z = (bf16x8){0, 0, 0, 0, 0, 0, 0, 0};
                aq[ks] = z;
            }
        }
        const bf16_t* kbase = P + rowbase * NPROJ + AK_OFF + 8 * hia;
        const bf16_t* vgbase = P + rowbase * NPROJ + AV_OFF + 8 * (ln & 7);
        u32x4 vr[8];
#define DSA_VLOAD(vt) do { _Pragma("unroll") for (int i_ = 0; i_ < 8; ++i_) { const int j_ = 64 * (vt) + 8 * i_ + (ln >> 3); \
            const int idx_ = (j_ < cnt) ? (int)LIST[j_] : 0; vr[i_] = *(const u32x4*)(vgbase + (size_t)idx_ * NPROJ); } } while (0)
        DSA_VLOAD(0);
        float sc[8][4];
        const int ntile = (cnt + 31) >> 5;
#pragma unroll
        for (int grp = 0; grp < 2; ++grp) {
            if (grp * 4 < ntile) {
                bf16x8 kb[4][4];
#pragma unroll
                for (int k4 = 0; k4 < 4; ++k4) {
                    const int j = 32 * (4 * grp + k4) + l32a;
                    const int idx = (j < cnt) ? (int)LIST[j] : 0;
                    const bf16_t* kr = kbase + (size_t)idx * NPROJ;
#pragma unroll
                    for (int ks = 0; ks < 4; ++ks) kb[k4][ks] = *(const bf16x8*)(kr + 16 * ks);
                }
#pragma unroll
                for (int k4 = 0; k4 < 4; ++k4) {
                    const int j = 32 * (4 * grp + k4) + l32a;
                    f32x16 D;
#pragma unroll
                    for (int r = 0; r < 16; ++r) D[r] = 0.f;
#pragma unroll
                    for (int ks = 0; ks < 4; ++ks) D = mfma32(aq[ks], kb[k4][ks], D);
                    const bool ok = (j < cnt) && (hia == 0);
#pragma unroll
                    for (int hh = 0; hh < 4; ++hh) sc[4 * grp + k4][hh] = ok ? D[hh] : -INFINITY;
                }
            } else {
#pragma unroll
                for (int k4 = 0; k4 < 4; ++k4)
#pragma unroll
                    for (int hh = 0; hh < 4; ++hh) sc[4 * grp + k4][hh] = -INFINITY;
            }
        }
        float lh[4];
#pragma unroll
        for (int hh = 0; hh < 4; ++hh) {
            float mx = sc[0][hh];
#pragma unroll
            for (int kt = 1; kt < 8; ++kt) mx = fmaxf(mx, sc[kt][hh]);
#pragma unroll
            for (int o = 1; o < 32; o <<= 1) mx = fmaxf(mx, __shfl_xor(mx, o));
            const float ms = (mx == -INFINITY) ? 0.f : mx;
            float sm = 0.f;
#pragma unroll
            for (int kt = 0; kt < 8; ++kt) { sc[kt][hh] = fexp2(sc[kt][hh] - ms); sm += sc[kt][hh]; }
#pragma unroll
            for (int o = 1; o < 32; o <<= 1) sm += __shfl_xor(sm, o);
            sm += __shfl_xor(sm, 32);
            lh[hh] = sm;
        }
        if (hia == 0) {
#pragma unroll
            for (int hh = 0; hh < 4; ++hh)
#pragma unroll
                for (int kt = 0; kt < 8; ++kt) PWb[hh * PW_LD + 32 * kt + l32a] = (bf16_t)(pk2(sc[kt][hh], 0.f) & 0xffffu);
        }
        asm volatile("s_waitcnt lgkmcnt(0)" ::: "memory");
        __builtin_amdgcn_wave_barrier();
        f32x16 oA, oB;
#pragma unroll
        for (int r = 0; r < 16; ++r) { oA[r] = 0.f; oB[r] = 0.f; }
        const int nvt = (cnt + 63) >> 6;
        const int tq = (ln & 15) >> 2, tp = ln & 3, tc = (ln >> 4) & 1;
#pragma unroll 1
        for (int vt = 0; vt < nvt; ++vt) {
#pragma unroll
            for (int i = 0; i < 8; ++i) *(u32x4*)(Vt + (8 * i + (ln >> 3)) * VTD_LD + 8 * (ln & 7)) = vr[i];
            asm volatile("s_waitcnt lgkmcnt(0)" ::: "memory");
            __builtin_amdgcn_wave_barrier();
            if (vt + 1 < nvt) DSA_VLOAD(vt + 1);
            const bf16_t* vtl = Vt + (8 * hia + tq) * VTD_LD + 16 * tc + 4 * tp;
            asm volatile("" : "+v"(vtl));
#pragma unroll
            for (int ks = 0; ks < 4; ++ks) {
                bf16x8 ap = *(const bf16x8*)(PWb + (l32a & 3) * PW_LD + 64 * vt + 16 * ks + 8 * hia);
                if (l32a >= 4) ap = (bf16x8){0, 0, 0, 0, 0, 0, 0, 0};
                const bf16_t* vrow = vtl + (16 * ks) * VTD_LD;
                const v4i16_t r1 = ds_tr16(vrow), r2 = ds_tr16(vrow + 4 * VTD_LD);
                const v4i16_t r3 = ds_tr16(vrow + 32), r4 = ds_tr16(vrow + 4 * VTD_LD + 32);
                const bf16x8 b0 = (bf16x8){r1[0], r1[1], r1[2], r1[3], r2[0], r2[1], r2[2], r2[3]};
                const bf16x8 b1 = (bf16x8){r3[0], r3[1], r3[2], r3[3], r4[0], r4[1], r4[2], r4[3]};
                oA = mfma32(ap, b0, oA); oB = mfma32(ap, b1, oB);
            }
            asm volatile("" : "+v"(oA), "+v"(oB));
            asm volatile("s_waitcnt lgkmcnt(0)" ::: "memory");
            __builtin_amdgcn_wave_barrier();
        }
#undef DSA_VLOAD
        if (hia == 0) {
            bf16_t* orow = MIX + row * DM + l32a;
#pragma unroll
            for (int hh = 0; hh < 4; ++hh) {
                const float il = 1.0f / lh[hh];
                orow[64 * hh] = (bf16_t)(pk2(oA[hh] * il, 0.f) & 0xffffu);
                orow[64 * hh + 32] = (bf16_t)(pk2(oB[hh] * il, 0.f) & 0xffffu);
            }
        }
        asm volatile("s_waitcnt lgkmcnt(0)" ::: "memory");
        __builtin_amdgcn_wave_barrier();
        }
    }
    __syncthreads();
}

constexpr int MB_VT = 0, MB_LIST = 8 * 64 * VTD_LD * 2, MB_WCNT = MB_LIST + 32 * 256 * 2, MB_END = MB_WCNT + 8 * 32 * 4;
static_assert(MB_END <= 131072 && FL_END <= MB_LIST, "MoBA LDS map");
constexpr int PART_LD = 68;
__device__ __forceinline__ void moba_unit(const bf16_t* __restrict__ P, const float* __restrict__ KMEAN, bf16_t* __restrict__ MIX, float* __restrict__ scr,
                                          int b, int h, int qt, char* lds) {
    int tid_ = threadIdx.x; asm volatile("" : "+v"(tid_));
    const int tid = tid_, lane = tid & 63, w = __builtin_amdgcn_readfirstlane(tid >> 6), l32 = lane & 31, hi = lane >> 5;
    constexpr int QOFF = BQ_OFF, KOFF = BK_OFF, VOFF = BV_OFF, OOFF = 256;
    const size_t rowbase = (size_t)b * SEQ;
    const int q0 = qt * 256 + w * 32, myq = q0 + l32, qlocal = w * 32 + l32;
    const bf16_t* qrow = P + (rowbase + myq) * NPROJ + QOFF + 64 * h;
    unsigned short* listb = (unsigned short*)(lds + MB_LIST);
    int* wcnt = (int*)(lds + MB_WCNT);
    bf16_t* Vt = (bf16_t*)(lds + MB_VT) + w * 64 * VTD_LD;
    int i1 = -1, i2 = -1, i3 = -1;
    {
        float v1 = -INFINITY, v2 = -INFINITY, v3 = -INFINITY;
        const float* km = KMEAN + ((size_t)(b * 4 + h) * 32) * 64;
        for (int n = 0; n < qt; ++n) {
            float gsum = 0.f;
#pragma unroll
            for (int c8 = 0; c8 < 8; ++c8) {
                const u32x4 qv = *(const u32x4*)(qrow + 8 * c8);
                const f32x4 k0 = *(const f32x4*)(km + n * 64 + 8 * c8), k1 = *(const f32x4*)(km + n * 64 + 8 * c8 + 4);
                gsum += __uint_as_float(qv.x << 16) * k0[0] + __uint_as_float(qv.x & 0xffff0000u) * k0[1] + __uint_as_float(qv.y << 16) * k0[2] + __uint_as_float(qv.y & 0xffff0000u) * k0[3]
                      + __uint_as_float(qv.z << 16) * k1[0] + __uint_as_float(qv.z & 0xffff0000u) * k1[1] + __uint_as_float(qv.w << 16) * k1[2] + __uint_as_float(qv.w & 0xffff0000u) * k1[3];
            }
            if (gsum > v3) {
                if (gsum > v1) { v3 = v2; i3 = i2; v2 = v1; i2 = i1; v1 = gsum; i1 = n; }
                else if (gsum > v2) { v3 = v2; i3 = i2; v2 = gsum; i2 = n; }
                else { v3 = gsum; i3 = n; }
            }
        }
    }
#ifdef DBG_ZERO_PART
    for (int i = tid; i < 256 * 3 * PART_LD / 4; i += NTHREADS) *(f32x4*)(scr + 4 * i) = (f32x4){0.f, 0.f, 0.f, 0.f};
#endif
    __syncthreads();
    for (int n = 0; n < qt; ++n) {
        const bool pr = (hi == 0) && (i1 == n || i2 == n || i3 == n);
        const unsigned long long mk = __ballot(pr);
        if (lane == 0) wcnt[w * 32 + n] = __builtin_popcountll(mk);
    }
    __syncthreads();
    for (int n = 0; n < qt; ++n) {
        const bool pr = (hi == 0) && (i1 == n || i2 == n || i3 == n);
        const unsigned long long mk = __ballot(pr);
        int base = 0;
        for (int ww = 0; ww < w; ++ww) base += wcnt[ww * 32 + n];
        if (pr) {
            const int slot = (i1 == n) ? 0 : ((i2 == n) ? 1 : 2);
            const int pre = __builtin_amdgcn_mbcnt_hi((unsigned)(mk >> 32), __builtin_amdgcn_mbcnt_lo((unsigned)mk, 0u));
            listb[n * 256 + base + pre] = (unsigned short)(qlocal | (slot << 8));
        }
    }
    __syncthreads();
    {
        const int tq = (lane & 15) >> 2, tp = lane & 3, tc = (lane >> 4) & 1;
        int it = 0;
#pragma unroll 1
        for (int n = 0; n < qt; ++n) {
            int cn = 0;
#pragma unroll
            for (int ww = 0; ww < 8; ++ww) cn += wcnt[ww * 32 + n];
            const int ng = (cn + 31) >> 5;
#pragma unroll 1
            for (int g = 0; g < ng; ++g, ++it) {
                if ((it & 7) != w) continue;
                const int j = 32 * g + l32; const bool valid = j < cn;
                const unsigned ent = listb[n * 256 + (valid ? j : 32 * g)];
                const int ql = (int)(ent & 255u), slot = (int)(ent >> 8);
                const bf16_t* qr = P + (rowbase + qt * 256 + ql) * NPROJ + QOFF + 64 * h;
                bf16x8 qf[4];
#pragma unroll
                for (int ks = 0; ks < 4; ++ks) qf[ks] = *(const bf16x8*)(qr + 16 * ks + 8 * hi);
                float m = -INFINITY, lsum = 0.f;
                f32x16 o0, o1;
#pragma unroll
                for (int r = 0; r < 16; ++r) { o0[r] = 0.f; o1[r] = 0.f; }
                const bf16_t* kb0 = P + (rowbase + 256 * n + l32) * NPROJ + KOFF + 64 * h + 8 * hi;
                const bf16_t* vb0 = P + (rowbase + 256 * n + (lane >> 3)) * NPROJ + VOFF + 64 * h + 8 * (lane & 7);
                bf16x8 ka[2][4]; u32x4 vr[8];
#define MB_LOADK(t_) do { _Pragma("unroll") for (int ks_ = 0; ks_ < 4; ++ks_) { ka[0][ks_] = *(const bf16x8*)(kb0 + (size_t)(64 * (t_)) * NPROJ + 16 * ks_); \
                                                                             ka[1][ks_] = *(const bf16x8*)(kb0 + (size_t)(64 * (t_) + 32) * NPROJ + 16 * ks_); } } while (0)
#define MB_LOADV(t_) do { _Pragma("unroll") for (int i_ = 0; i_ < 8; ++i_) vr[i_] = *(const u32x4*)(vb0 + (size_t)(64 * (t_) + 8 * i_) * NPROJ); } while (0)
                MB_LOADK(0); MB_LOADV(0);
#pragma unroll 1
                for (int t = 0; t < 4; ++t) {
                    f32x16 s0, s1;
#pragma unroll
                    for (int r = 0; r < 16; ++r) { s0[r] = 0.f; s1[r] = 0.f; }
#pragma unroll
                    for (int ks = 0; ks < 4; ++ks) { s0 = mfma32(ka[0][ks], qf[ks], s0); s1 = mfma32(ka[1][ks], qf[ks], s1); }
                    asm volatile("" : "+v"(s0), "+v"(s1));
                    if (t + 1 < 4) MB_LOADK(t + 1);
#pragma unroll
                    for (int i = 0; i < 8; ++i) *(u32x4*)(Vt + (8 * i + (lane >> 3)) * VTD_LD + 8 * (lane & 7)) = vr[i];
                    asm volatile("s_waitcnt lgkmcnt(0)" ::: "memory");
                    __builtin_amdgcn_wave_barrier();
                    float mxa = max3f(s0[0], s0[1], s0[2]), mxb = max3f(s1[0], s1[1], s1[2]);
#pragma unroll
                    for (int r = 3; r < 15; r += 2) { mxa = max3f(mxa, s0[r], s0[r + 1]); mxb = max3f(mxb, s1[r], s1[r + 1]); }
                    float mx = max3f(mxa, mxb, s0[15]); mx = max2f(mx, s1[15]);
                    mx = max2f(mx, __shfl_xor(mx, 32));
                    const float mnew = max2f(m, mx);
                    const float alpha = fexp2(m - mnew);
                    float psum = 0.f;
#pragma unroll
                    for (int r = 0; r < 16; ++r) { s0[r] = fexp2(s0[r] - mnew); s1[r] = fexp2(s1[r] - mnew); psum += s0[r] + s1[r]; }
                    lsum = lsum * alpha + psum; m = mnew;
#pragma unroll
                    for (int r = 0; r < 16; ++r) { o0[r] *= alpha; o1[r] *= alpha; }
                    bf16x8 pk[4];
                    {
                        u32x4 tt;
                        tt.x = pk2(s0[0], s0[1]); tt.y = pk2(s0[2], s0[3]); tt.z = pk2(s0[4], s0[5]); tt.w = pk2(s0[6], s0[7]); pk[0] = __builtin_bit_cast(bf16x8, tt);
                        tt.x = pk2(s0[8], s0[9]); tt.y = pk2(s0[10], s0[11]); tt.z = pk2(s0[12], s0[13]); tt.w = pk2(s0[14], s0[15]); pk[1] = __builtin_bit_cast(bf16x8, tt);
                        tt.x = pk2(s1[0], s1[1]); tt.y = pk2(s1[2], s1[3]); tt.z = pk2(s1[4], s1[5]); tt.w = pk2(s1[6], s1[7]); pk[2] = __builtin_bit_cast(bf16x8, tt);
                        tt.x = pk2(s1[8], s1[9]); tt.y = pk2(s1[10], s1[11]); tt.z = pk2(s1[12], s1[13]); tt.w = pk2(s1[14], s1[15]); pk[3] = __builtin_bit_cast(bf16x8, tt);
                    }
                    asm volatile("" : "+v"(pk[0]), "+v"(pk[1]), "+v"(pk[2]), "+v"(pk[3]));
                    const bf16_t* vtl = Vt + (4 * hi + tq) * VTD_LD + 16 * tc + 4 * tp;
                    asm volatile("" : "+v"(vtl));
#pragma unroll
                    for (int kk = 0; kk < 4; ++kk) {
                        const bf16_t* vrow = vtl + (16 * kk) * VTD_LD;
                        const v4i16_t r1 = ds_tr16(vrow), r2 = ds_tr16(vrow + 8 * VTD_LD);
                        const v4i16_t r3 = ds_tr16(vrow + 32), r4 = ds_tr16(vrow + 8 * VTD_LD + 32);
                        const bf16x8 a0 = (bf16x8){r1[0], r1[1], r1[2], r1[3], r2[0], r2[1], r2[2], r2[3]};
                        const bf16x8 a1 = (bf16x8){r3[0], r3[1], r3[2], r3[3], r4[0], r4[1], r4[2], r4[3]};
                        o0 = mfma32(a0, pk[kk], o0); o1 = mfma32(a1, pk[kk], o1);
                    }
                    asm volatile("" : "+v"(o0), "+v"(o1));
                    asm volatile("s_waitcnt lgkmcnt(0)" ::: "memory");
                    __builtin_amdgcn_wave_barrier();
                    if (t + 1 < 4) MB_LOADV(t + 1);
                }
#undef MB_LOADK
#undef MB_LOADV
                const float ltot = lsum + __shfl_xor(lsum, 32);
                if (valid) {
                    float* pb = scr + (size_t)(ql * 3 + slot) * PART_LD;
#pragma unroll
                    for (int g4 = 0; g4 < 4; ++g4) {
                        f32x4 x0, x1;
                        x0[0] = o0[4 * g4]; x0[1] = o0[4 * g4 + 1]; x0[2] = o0[4 * g4 + 2]; x0[3] = o0[4 * g4 + 3];
                        x1[0] = o1[4 * g4]; x1[1] = o1[4 * g4 + 1]; x1[2] = o1[4 * g4 + 2]; x1[3] = o1[4 * g4 + 3];
                        *(f32x4*)(pb + 8 * g4 + 4 * hi) = x0; *(f32x4*)(pb + 32 + 8 * g4 + 4 * hi) = x1;
                    }
                    if (hi == 0) { pb[64] = m; pb[65] = ltot; }
                }
            }
        }
    }
    __syncthreads();
    __builtin_amdgcn_fence(__ATOMIC_ACQUIRE, "agent");
    bf16x8 qf[4];
#pragma unroll
    for (int ks = 0; ks < 4; ++ks) qf[ks] = *(const bf16x8*)(qrow + 16 * ks + 8 * hi);
    float m = -INFINITY, lsum = 0.f;
    f32x16 o0, o1;
#pragma unroll
    for (int r = 0; r < 16; ++r) { o0[r] = 0.f; o1[r] = 0.f; }
    const int NT = 4 * qt + 4;
    const int kkey = tid >> 3, kch = tid & 7;
    const int vkey = 16 * (w & 3) + (lane & 15), vch = 4 * (w >> 2) + (lane >> 4);
    u32x4 kreg, vreg;
#define MBF_LOAD(kt_) do { kreg = *(const u32x4*)(P + (rowbase + 64 * (kt_) + kkey) * NPROJ + KOFF + 64 * h + 8 * kch); \
        vreg = *(const u32x4*)(P + (rowbase + 64 * (kt_) + vkey) * NPROJ + VOFF + 64 * h + 8 * vch); } while (0)
#define MBF_STORE(buf_) do { bf16_t* Kd_ = (bf16_t*)(lds + (buf_) * FL_BUF + FL_KS); bf16_t* Vd_ = (bf16_t*)(lds + (buf_) * FL_BUF + FL_VT); \
        *(u32x4*)(Kd_ + kkey * KS_LD + 8 * kch) = kreg; \
        bf16_t* vd = Vd_ + (8 * vch) * VT_LD + vkey; \
        vd[0 * VT_LD] = (bf16_t)(vreg.x & 0xffffu); vd[1 * VT_LD] = (bf16_t)(vreg.x >> 16); \
        vd[2 * VT_LD] = (bf16_t)(vreg.y & 0xffffu); vd[3 * VT_LD] = (bf16_t)(vreg.y >> 16); \
        vd[4 * VT_LD] = (bf16_t)(vreg.z & 0xffffu); vd[5 * VT_LD] = (bf16_t)(vreg.z >> 16); \
        vd[6 * VT_LD] = (bf16_t)(vreg.w & 0xffffu); vd[7 * VT_LD] = (bf16_t)(vreg.w >> 16); } while (0)
    int kt = 4 * qt;
    MBF_LOAD(kt);
    MBF_STORE(0);
    __syncthreads();
    int cur = 0;
    while (kt < NT) {
        const int ktc = kt;
        if (kt + 1 < NT) MBF_LOAD(kt + 1);
        ++kt;
        const bf16_t* Ks = (const bf16_t*)(lds + cur * FL_BUF + FL_KS); const bf16_t* VT = (const bf16_t*)(lds + cur * FL_BUF + FL_VT);
        if (!(64 * ktc > q0 + 31)) {
            f32x16 s0, s1;
#pragma unroll
            for (int r = 0; r < 16; ++r) { s0[r] = 0.f; s1[r] = 0.f; }
#pragma unroll
            for (int ks = 0; ks < 4; ++ks) {
                const bf16x8 a0 = *(const bf16x8*)(Ks + l32 * KS_LD + 16 * ks + 8 * hi);
                const bf16x8 a1 = *(const bf16x8*)(Ks + (32 + l32) * KS_LD + 16 * ks + 8 * hi);
                s0 = mfma32(a0, qf[ks], s0); s1 = mfma32(a1, qf[ks], s1);
            }
            if (64 * ktc + 63 > q0) {
#pragma unroll
                for (int r = 0; r < 16; ++r) {
                    const int kg = 64 * ktc + 8 * (r >> 2) + 4 * hi + (r & 3);
                    if (kg > myq) s0[r] = -INFINITY;
                    if (kg + 32 > myq) s1[r] = -INFINITY;
                }
            }
            float mxa = max3f(s0[0], s0[1], s0[2]), mxb = max3f(s1[0], s1[1], s1[2]);
#pragma unroll
            for (int r = 3; r < 15; r += 2) { mxa = max3f(mxa, s0[r], s0[r + 1]); mxb = max3f(mxb, s1[r], s1[r + 1]); }
            float mx = max3f(mxa, mxb, s0[15]); mx = max2f(mx, s1[15]);
            mx = max2f(mx, __shfl_xor(mx, 32));
            const float mnew = max2f(m, mx);
            const float msafe = (mnew == -INFINITY) ? 0.f : mnew;
            const float alpha = fexp2(m - msafe);
            float psum = 0.f;
#pragma unroll
            for (int r = 0; r < 16; ++r) { s0[r] = fexp2(s0[r] - msafe); s1[r] = fexp2(s1[r] - msafe); psum += s0[r] + s1[r]; }
            lsum = lsum * alpha + psum; m = mnew;
#pragma unroll
            for (int r = 0; r < 16; ++r) { o0[r] *= alpha; o1[r] *= alpha; }
            bf16x8 pk[4];
            {
                u32x4 tt;
                tt.x = pk2(s0[0], s0[1]); tt.y = pk2(s0[2], s0[3]); tt.z = pk2(s0[4], s0[5]); tt.w = pk2(s0[6], s0[7]); pk[0] = __builtin_bit_cast(bf16x8, tt);
                tt.x = pk2(s0[8], s0[9]); tt.y = pk2(s0[10], s0[11]); tt.z = pk2(s0[12], s0[13]); tt.w = pk2(s0[14], s0[15]); pk[1] = __builtin_bit_cast(bf16x8, tt);
                tt.x = pk2(s1[0], s1[1]); tt.y = pk2(s1[2], s1[3]); tt.z = pk2(s1[4], s1[5]); tt.w = pk2(s1[6], s1[7]); pk[2] = __builtin_bit_cast(bf16x8, tt);
                tt.x = pk2(s1[8], s1[9]); tt.y = pk2(s1[10], s1[11]); tt.z = pk2(s1[12], s1[13]); tt.w = pk2(s1[14], s1[15]); pk[3] = __builtin_bit_cast(bf16x8, tt);
            }
#pragma unroll
            for (int kk = 0; kk < 4; ++kk) {
                u32x4 a, c;
                const u32x2 a_lo = *(const u32x2*)(VT + l32 * VT_LD + 16 * kk + 4 * hi), a_hi = *(const u32x2*)(VT + l32 * VT_LD + 16 * kk + 8 + 4 * hi);
                const u32x2 c_lo = *(const u32x2*)(VT + (32 + l32) * VT_LD + 16 * kk + 4 * hi), c_hi = *(const u32x2*)(VT + (32 + l32) * VT_LD + 16 * kk + 8 + 4 * hi);
                a.x = a_lo.x; a.y = a_lo.y; a.z = a_hi.x; a.w = a_hi.y; c.x = c_lo.x; c.y = c_lo.y; c.z = c_hi.x; c.w = c_hi.y;
                o0 = mfma32(__builtin_bit_cast(bf16x8, a), pk[kk], o0);
                o1 = mfma32(__builtin_bit_cast(bf16x8, c), pk[kk], o1);
            }
        }
        if (kt < NT) MBF_STORE(cur ^ 1);
        __syncthreads();
        cur ^= 1;
    }
#undef MBF_LOAD
#undef MBF_STORE
    float ltot = lsum + __shfl_xor(lsum, 32);
#pragma unroll
    for (int sl = 0; sl < 3; ++sl) {
        const int bi = (sl == 0) ? i1 : ((sl == 1) ? i2 : i3);
#ifdef DBG_NOMERGE
        if (bi >= 1000 + (int)blockIdx.x) {
#else
        if (bi >= 0) {
#endif
            float* pb = scr + (size_t)(qlocal * 3 + sl) * PART_LD;
            const float mp = pb[64], lp = pb[65];
            const float mn = max2f(m, mp);
            const float fa = fexp2(m - mn), fb = fexp2(mp - mn);
            ltot = ltot * fa + lp * fb; m = mn;
#pragma unroll
            for (int g4 = 0; g4 < 4; ++g4) {
                const f32x4 x0 = *(const f32x4*)(pb + 8 * g4 + 4 * hi), x1 = *(const f32x4*)(pb + 32 + 8 * g4 + 4 * hi);
#pragma unroll
                for (int i = 0; i < 4; ++i) { o0[4 * g4 + i] = o0[4 * g4 + i] * fa + x0[i] * fb; o1[4 * g4 + i] = o1[4 * g4 + i] * fa + x1[i] * fb; }
            }
        }
    }
    const float inv = 1.0f / ltot;
    bf16_t* orow = MIX + (rowbase + myq) * DM + OOFF + 64 * h;
#pragma unroll
    for (int g4 = 0; g4 < 4; ++g4) {
        const int d = 8 * g4 + 4 * hi;
        u32x2 wa, wc2;
        wa.x = pk2(o0[4 * g4] * inv, o0[4 * g4 + 1] * inv); wa.y = pk2(o0[4 * g4 + 2] * inv, o0[4 * g4 + 3] * inv);
        wc2.x = pk2(o1[4 * g4] * inv, o1[4 * g4 + 1] * inv); wc2.y = pk2(o1[4 * g4 + 2] * inv, o1[4 * g4 + 3] * inv);
        *(u32x2*)(orow + d) = wa; *(u32x2*)(orow + 32 + d) = wc2;
    }
    __syncthreads();
}

constexpr int UNITS_PER_LEVEL = 8 + 4 + 8, N_ATT_UNITS = 32 * UNITS_PER_LEVEL;
__device__ __forceinline__ void attn_phase(const bf16_t* P, const float* IW, const float* CUM, const float* KMEAN, bf16_t* MIX, float* scr, unsigned* counters, const float* gq, const float* gk, char* lds) {
    int* s_unit = (int*)(lds + MISC_OFF);
    for (int qi = 0; qi < NB; ++qi) {
        const int b = (int)((blockIdx.x + qi) & (NB - 1));
        unsigned* counter = counters + 64 * b;
        __syncthreads();
        if (threadIdx.x == 0) *s_unit = (int)atomicAdd(counter, 1u);
        for (;;) {
            __syncthreads();
            const int u = *s_unit;
            __syncthreads();
            if (u >= N_ATT_UNITS) break;
            const bool pre = u < N_ATT_UNITS - 8 * UNITS_PER_LEVEL;
            if (pre && threadIdx.x == 0) *s_unit = (int)atomicAdd(counter, 1u);
            const int lvl = 31 - u / UNITS_PER_LEVEL, j = u % UNITS_PER_LEVEL;
            int reps_f = 1, reps_d = 1;
#ifdef PROBE_FLASH2
            reps_f = 2;
#endif
#ifdef PROBE_DSA2
            reps_d = 2;
#endif
#pragma unroll 1
            for (int rep_ = 0; rep_ < (j < 12 ? reps_f : reps_d); ++rep_) {
                if (j < 8) flash_unit<0>(P, CUM, KMEAN, MIX, gq, gk, b, j, lvl, lds);
#ifdef MOBA_DENSE
                else if (j < 12) flash_unit<1>(P, CUM, KMEAN, MIX, gq, gk, b, j - 8, lvl, lds);
#else
                else if (j < 12) moba_unit(P, KMEAN, MIX, scr, b, j - 8, lvl, lds);
#endif
                else dsa_unit(P, IW, MIX, scr, b, 8 * lvl + (j - 12), lds);
            }
            if (!pre && threadIdx.x == 0) *s_unit = (int)atomicAdd(counter, 1u);
        }
    }
}

constexpr int N_PHASES = 1 + 8 * DEPTH;
#define PH_IN(p) (lo <= (p) && (p) < hi)
#define PH_SYNC(p) do { if (PH_IN(p) && PH_IN((p) + 1)) cg::this_grid().sync(); } while (0)
__device__ __forceinline__ void prologue_phase(const Args& args, char* lds) {
    unsigned char* ws = args.ws;
    const int tid = threadIdx.x, lane = tid & 63, wave = tid >> 6;
    float* scr = (float*)(lds + wave * 16384);
    const int gw = blockIdx.x * 8 + wave, ngw = gridDim.x * 8;
    for (int mat = 0; mat < 16; ++mat) {
        const int l = mat >> 3, k = mat & 7;
        const float* src; const float* gain = nullptr; int K, N, kind; size_t dst;
        if (k == 0) { src = args.in[2] + (size_t)l * DM * DFF; gain = args.in[1] + l * DM; K = DM; N = DFF; kind = 1; dst = WL_GU1; }
        else if (k == 1) { src = args.in[3] + (size_t)l * DM * DFF; gain = args.in[1] + l * DM; K = DM; N = DFF; kind = 2; dst = WL_GU1; }
        else if (k == 2) { src = args.in[4] + (size_t)l * DFF * DM; K = DFF; N = DM; kind = 0; dst = WL_D1; }
        else if (k == 3) { src = args.in[16] + (size_t)l * DM * DFF; gain = args.in[15] + l * DM; K = DM; N = DFF; kind = 1; dst = WL_GU2; }
        else if (k == 4) { src = args.in[17] + (size_t)l * DM * DFF; gain = args.in[15] + l * DM; K = DM; N = DFF; kind = 2; dst = WL_GU2; }
        else if (k == 5) { src = args.in[18] + (size_t)l * DFF * DM; K = DFF; N = DM; kind = 0; dst = WL_D2; }
        else if (k == 6) { src = args.in[6] + (size_t)l * DM * INW; gain = args.in[5] + l * DM; K = DM; N = INW; kind = 3; dst = WL_IN; }
        else { src = args.in[14] + (size_t)l * DM * DM; K = DM; N = DM; kind = 0; dst = WL_OUT; }
        bf16_t* WT = (bf16_t*)(ws + WS_W + (size_t)l * WL_BYTES + dst);
        const int nitems = (K / 64) * ((N + 31) / 32);
        for (int it = gw; it < nitems; it += ngw) transpose_item(src, gain, K, N, WT, kind, scr, it, lane);
    }
    for (int i = blockIdx.x * NTHREADS + tid; i < DEPTH * 48 * 128; i += gridDim.x * NTHREADS) {
        const int l = i / (48 * 128), r = (i / 128) % 48, c = i % 128, d = 16 + r;
        bf16_t* WT = (bf16_t*)(ws + WS_W + (size_t)l * WL_BYTES + WL_IN);
        *(u32x4*)(WT + (size_t)(256 * 14 + 128 * (d >> 5) + 96 + (d & 31)) * DM + 8 * c) = (u32x4){0u, 0u, 0u, 0u};
    }
    float* COS = (float*)(ws + WS_COS); float* SIN = (float*)(ws + WS_SIN);
    for (int i = blockIdx.x * NTHREADS + tid; i < SEQ * 32; i += gridDim.x * NTHREADS) {
        const int pos = i >> 5, f = i & 31;
        const float inv = 1.0f / powf(10000.0f, (float)(2 * f) / 64.0f);
        const float ang = (float)pos * inv;
        COS[i] = (float)cos((double)ang); SIN[i] = (float)sin((double)ang);
    }
    float* SS = (float*)(ws + WS_SS);
    for (int m0 = 4 * gw; m0 < MTOK; m0 += 4 * ngw) {
        f32x4 v[4][4];
#pragma unroll
        for (int r = 0; r < 4; ++r)
#pragma unroll
            for (int j = 0; j < 4; ++j) v[r][j] = *((const f32x4*)(args.in[0] + (size_t)(m0 + r) * DM) + lane + 64 * j);
#pragma unroll
        for (int r = 0; r < 4; ++r) {
            float sq = 0.f;
#pragma unroll
            for (int j = 0; j < 4; ++j) sq += (v[r][j][0] * v[r][j][0] + v[r][j][1] * v[r][j][1]) + (v[r][j][2] * v[r][j][2] + v[r][j][3] * v[r][j][3]);
            sq = wave_sum(sq);
            u32x2* o8 = (u32x2*)((bf16_t*)(ws + WS_XN) + (size_t)(m0 + r) * DM) + lane;
#pragma unroll
            for (int j = 0; j < 4; ++j) { u32x2 wv; wv.x = pk2(v[r][j][0], v[r][j][1]); wv.y = pk2(v[r][j][2], v[r][j][3]); o8[64 * j] = wv; }
            if (lane < 16) SS[(size_t)(m0 + r) * 16 + lane] = (lane == 0) ? sq : 0.f;
        }
    }
}
template <int L>
__device__ __forceinline__ void layer_phases(const Args& args, unsigned char* lds_raw, const int lo, const int hi) {
    char* lds = (char*)lds_raw;
    unsigned char* ws = args.ws;
    constexpr int P0 = 1 + 8 * L;
    float* SSb = (float*)(ws + WS_SS);
    if (PH_IN(P0 + 0)) {
        pg8::Gemm g{(const bf16_t*)(ws + WS_XN), (const bf16_t*)(ws + WS_W + (size_t)L * WL_BYTES + WL_GU1), MTOK, 2 * DFF, DM};
        pg8::StaticOrder S; S.init(MTOK, 2 * DFF, (int)gridDim.x, (int)blockIdx.x);
        EpiSwiglu E{(bf16_t*)(ws + WS_BIG), SSb + (size_t)(3 * L + 0) * MTOK * 16};
        pg8::gemm_phase<EpiSwiglu, pg8::StaticOrder, true, true>((PG8_LAS unsigned char*)lds_raw, g, S, E);
#ifdef PROBE_GU2
        __syncthreads();
        pg8::gemm_phase<EpiSwiglu, pg8::StaticOrder, true, true>((PG8_LAS unsigned char*)lds_raw, g, S, E);
#endif
    }
    PH_SYNC(P0 + 0);
    if (PH_IN(P0 + 1)) {
        pg8::Gemm g{(const bf16_t*)(ws + WS_BIG), (const bf16_t*)(ws + WS_W + (size_t)L * WL_BYTES + WL_D1), MTOK, DM, DFF};
        pg8::StaticOrder S; S.init(MTOK, DM, (int)gridDim.x, (int)blockIdx.x);
        EpiResid<true, 1> E{L == 0 ? args.in[0] : args.out, args.out, (bf16_t*)(ws + WS_XN), SSb + (size_t)(3 * L + 1) * MTOK * 16};
        pg8::gemm_phase<EpiResid<true, 1>, pg8::StaticOrder, false, true>((PG8_LAS unsigned char*)lds_raw, g, S, E);
    }
    PH_SYNC(P0 + 1);
    if (PH_IN(P0 + 2)) {
        pg8::Gemm g{(const bf16_t*)(ws + WS_XN), (const bf16_t*)(ws + WS_W + (size_t)L * WL_BYTES + WL_IN), MTOK, NPROJ, DM};
        pg8::StaticOrder S; S.init(MTOK, NPROJ, (int)gridDim.x, (int)blockIdx.x);
        EpiProj E{(bf16_t*)(ws + WS_BIG), (float*)(ws + WS_IW), (float*)(ws + WS_LF), (const float*)(ws + WS_COS), (const float*)(ws + WS_SIN),
                  args.in[8] + L * 64, args.in[9] + L * 64, args.in[10] + L * 64, args.in[11] + L * 64, args.in[12] + L * 64, args.in[13] + L * 64, args.in[7] + L * 8,
                  SSb + (size_t)(3 * L + 1) * MTOK * 16};
        pg8::gemm_phase<EpiProj, pg8::StaticOrder, true, true>((PG8_LAS unsigned char*)lds_raw, g, S, E);
#ifdef PROBE_IN2
        __syncthreads();
        pg8::gemm_phase<EpiProj, pg8::StaticOrder, true, true>((PG8_LAS unsigned char*)lds_raw, g, S, E);
#endif
    }
    PH_SYNC(P0 + 2);
    if (PH_IN(P0 + 3)) scan_kmean_phase((const float*)(ws + WS_LF), (float*)(ws + WS_CUM), (const bf16_t*)(ws + WS_BIG), (float*)(ws + WS_KMEAN), lds);
#ifdef PROBE_SCAN2
    if (PH_IN(P0 + 3)) { __syncthreads(); scan_kmean_phase((const float*)(ws + WS_LF), (float*)(ws + WS_CUM), (const bf16_t*)(ws + WS_BIG), (float*)(ws + WS_KMEAN), lds); }
#endif
    PH_SYNC(P0 + 3);
    if (PH_IN(P0 + 4))
        attn_phase((const bf16_t*)(ws + WS_BIG), (const float*)(ws + WS_IW), (const float*)(ws + WS_CUM), (const float*)(ws + WS_KMEAN), (bf16_t*)(ws + WS_XN),
                   (float*)(ws + WS_SCR) + (size_t)blockIdx.x * 32 * SEQ, (unsigned*)(ws + WS_CTL) + 64 * 8 * L, args.in[12] + L * 64, args.in[13] + L * 64, lds);
    PH_SYNC(P0 + 4);
    if (PH_IN(P0 + 5)) {
        pg8::Gemm g{(const bf16_t*)(ws + WS_XN), (const bf16_t*)(ws + WS_W + (size_t)L * WL_BYTES + WL_OUT), MTOK, DM, DM};
        pg8::StaticOrder S; S.init(MTOK, DM, (int)gridDim.x, (int)blockIdx.x);
        EpiResid<true, 2> E{args.out, args.out, (bf16_t*)(ws + WS_HBB), SSb + (size_t)(3 * L + 2) * MTOK * 16};
        pg8::gemm_phase<EpiResid<true, 2>, pg8::StaticOrder, false, true>((PG8_LAS unsigned char*)lds_raw, g, S, E);
    }
    PH_SYNC(P0 + 5);
    if (PH_IN(P0 + 6)) {
        pg8::Gemm g{(const bf16_t*)(ws + WS_HBB), (const bf16_t*)(ws + WS_W + (size_t)L * WL_BYTES + WL_GU2), MTOK, 2 * DFF, DM};
        pg8::StaticOrder S; S.init(MTOK, 2 * DFF, (int)gridDim.x, (int)blockIdx.x);
        EpiSwiglu E{(bf16_t*)(ws + WS_BIG), SSb + (size_t)(3 * L + 2) * MTOK * 16};
        pg8::gemm_phase<EpiSwiglu, pg8::StaticOrder, true, true>((PG8_LAS unsigned char*)lds_raw, g, S, E);
    }
    PH_SYNC(P0 + 6);
    if (PH_IN(P0 + 7)) {
        pg8::Gemm g{(const bf16_t*)(ws + WS_BIG), (const bf16_t*)(ws + WS_W + (size_t)L * WL_BYTES + WL_D2), MTOK, DM, DFF};
        pg8::StaticOrder S; S.init(MTOK, DM, (int)gridDim.x, (int)blockIdx.x);
        EpiResid<(L + 1 < DEPTH), 1> E{args.out, args.out, (bf16_t*)(ws + WS_XN), SSb + (size_t)(3 * (L + 1 < DEPTH ? L + 1 : 0)) * MTOK * 16};
        pg8::gemm_phase<EpiResid<(L + 1 < DEPTH), 1>, pg8::StaticOrder, false, true>((PG8_LAS unsigned char*)lds_raw, g, S, E);
    }
    PH_SYNC(P0 + 7);
}
__global__ void __launch_bounds__(NTHREADS, 2) fwd_kernel(Args args) {
    extern __shared__ __attribute__((aligned(16))) unsigned char lds_raw[];
    const int lo = args.ph_lo, hi = args.ph_hi;
    if (PH_IN(0)) prologue_phase(args, (char*)lds_raw);
#ifdef PROBE_PRO2
    if (PH_IN(0)) { __syncthreads(); prologue_phase(args, (char*)lds_raw); }
#endif
    PH_SYNC(0);
    layer_phases<0>(args, lds_raw, lo, hi);
    layer_phases<1>(args, lds_raw, lo, hi);
}

extern "C" void kernel_launch(void* const* d_in, const int* in_sizes, int n_in, void* d_out, int out_size, void* d_ws, size_t ws_size, hipStream_t stream) {
    static int grid = 0;
    if (grid == 0) {
        if (n_in != 19 || out_size != MTOK * DM || ws_size < WS_END) { fprintf(stderr, "kernel_launch: unexpected shapes (n_in %d out %d ws %zu)\n", n_in, out_size, ws_size); grid = -1; return; }
        int dev = 0, cus = 0, per_cu = 0;
        hipGetDevice(&dev); hipDeviceGetAttribute(&cus, hipDeviceAttributeMultiprocessorCount, dev);
        hipFuncSetAttribute((const void*)fwd_kernel, hipFuncAttributeMaxDynamicSharedMemorySize, LDS_BYTES);
        hipOccupancyMaxActiveBlocksPerMultiprocessor(&per_cu, (const void*)fwd_kernel, NTHREADS, LDS_BYTES);
        (void)hipGetLastError();
        grid = cus * (per_cu < 1 ? 1 : 1);
        if (grid > 256) grid = 256;
        if (grid < 1) grid = 256;
    }
    if (grid < 0) return;
    hipMemsetAsync((char*)d_ws + WS_CTL, 0, 4096, stream);
    Args a{};
    for (int i = 0; i < 19; ++i) a.in[i] = (const float*)d_in[i];
    a.out = (float*)d_out; a.ws = (unsigned char*)d_ws;
#if MK_ONE_LAUNCH
    a.ph_lo = 0; a.ph_hi = N_PHASES;
    void* kargs[] = {&a};
    hipError_t e = hipLaunchCooperativeKernel((const void*)fwd_kernel, dim3(grid), dim3(NTHREADS), kargs, LDS_BYTES, stream);
    if (e != hipSuccess) fprintf(stderr, "cooperative launch failed: %s (grid %d)\n", hipGetErrorString(e), grid);
#else
    for (int ph = 0; ph < N_PHASES; ++ph) {
        a.ph_lo = ph; a.ph_hi = ph + 1;
        hipLaunchKernelGGL(fwd_kernel, dim3(grid), dim3(NTHREADS), LDS_BYTES, stream, a);
    }
#endif
}
```

```cpp
#include <hip/hip_runtime.h>
#include <hip/hip_cooperative_groups.h>
#include <cstdio>
#include <cstdint>
namespace cg = cooperative_groups;
namespace pg8 {
#define PG8_LAS __attribute__((address_space(3)))
typedef unsigned short bf16_t;
typedef short bf16x8 __attribute__((ext_vector_type(8)));
typedef float f32x4 __attribute__((ext_vector_type(4)));
typedef unsigned u32x4 __attribute__((ext_vector_type(4)));
constexpr int BM = 256, BK = 64, HALF = 128, HTB = HALF * BK * 2  , STAGE_BYTES = 8 * HTB, NXCD = 8, WGM = 8;

__host__ __device__ __forceinline__ int lds_byte(int r, int c) { const int st = (r >> 4) * 2 + (c >> 5), rr = r & 15, cc = c & 31, ob = rr * 64 + cc * 2; return st * 1024 + (ob ^ (((ob >> 9) & 1) << 5)); }
__host__ __device__ __forceinline__ void stage_rc(int b, int& R, int& C) { const int st = b / 1024, sb = b % 1024, swz = sb ^ (((sb >> 9) & 1) << 5); R = (st >> 1) * 16 + swz / 64; C = (st & 1) * 32 + (swz % 64) / 2; }
__host__ __device__ __forceinline__ int perm32(int rho) { const int n = rho >> 4, i = rho & 15; return 8 * (i >> 2) + 4 * n + (i & 3); }

struct Unit { int pm, pn; };
struct Gemm { const bf16_t* A; const bf16_t* Bt; int M, N, K; };

struct StaticOrder {
    int nM, nN, nwg, G, c;
    __host__ __device__ void init(int M, int N, int G_, int c_) { nM = M / BM; nN = N / BM; nwg = nM * nN; G = G_; c = c_; }
    __host__ __device__ bool next(int i, Unit& u) const {
        const long L = (long)i * G + c; if (L >= nwg) return false;
        int wgid = (int)L; { const int q = nwg / NXCD, r = nwg % NXCD, xcd = wgid % NXCD, off = wgid / NXCD; wgid = (xcd < r ? xcd * (q + 1) : r * (q + 1) + (xcd - r) * q) + off; }
        const int nig = WGM * nN, gid = wgid / nig, fm = gid * WGM, gsz = (nM - fm) < WGM ? (nM - fm) : WGM;
        u.pm = fm + ((wgid % nig) % gsz); u.pn = (wgid % nig) / gsz; return true;
    }
    __device__ __forceinline__ void a_ready(const Unit&) const {}
    __device__ __forceinline__ void done(const Unit&) const {}
};

__device__ __forceinline__ unsigned cvt_pk_bf16(float lo, float hi) { unsigned r; asm volatile("v_cvt_pk_bf16_f32 %0, %1, %2" : "=v"(r) : "v"(lo), "v"(hi)); return r; }
template <class Epi, class Sched, bool ALIGN_EPI = false, bool SP2 = false>
__device__ __forceinline__ void gemm_phase(PG8_LAS unsigned char* lds, const Gemm g, const Sched& S, const Epi& E) {
    const int tid = threadIdx.x, wid = __builtin_amdgcn_readfirstlane(tid >> 6), lane = tid & 63, wr = wid >> 2, wc = wid & 3, fr = lane & 15, fq = lane >> 4;
    const int K = g.K, nt = K / BK;
    unsigned voffA[2], voffB[2];
#pragma unroll
    for (int i = 0; i < 2; ++i) { int R, C; stage_rc(tid * 16 + i * 8192, R, C); const int Rb = Epi::PERM ? ((R & ~31) + perm32(R & 31)) : R;
        voffA[i] = (unsigned)(R * K + C) * 2u; voffB[i] = (unsigned)(Rb * K + C) * 2u; }
    const size_t kstep = (size_t)(BK * 2);
    const size_t hstep = (size_t)HALF * K * 2;
    const size_t tstep = 2 * hstep;
    const unsigned ldsw = (unsigned)wid * 1024u;
    const int aoff = lds_byte(wr * 64 + fr, fq * 8), boff = lds_byte(wc * 32 + fr, fq * 8);
#define PG8_SA(b, h) (((b) * 2 + (h)) * HTB)
#define PG8_SB(b, h) ((4 + (b) * 2 + (h)) * HTB)
#define PG8_STAGE(bufoff, gbase, voff) do { _Pragma("unroll") for (int _i = 0; _i < 2; ++_i) \
        __builtin_amdgcn_global_load_lds((const unsigned*)((const char*)(gbase) + (voff)[_i]), (PG8_LAS unsigned*)(lds + (bufoff) + ldsw + _i * 8192), 16, 0, 0); } while (0)
#define PG8_LDA(dst, b, h) do { _Pragma("unroll") for (int m = 0; m < 4; ++m) _Pragma("unroll") for (int k = 0; k < 2; ++k) dst[m][k] = *(const PG8_LAS bf16x8*)(lds + PG8_SA(b, h) + aoff + m * 2048 + k * 1024); } while (0)
#define PG8_LDB(dst, b, h) do { _Pragma("unroll") for (int n = 0; n < 2; ++n) _Pragma("unroll") for (int k = 0; k < 2; ++k) dst[n][k] = *(const PG8_LAS bf16x8*)(lds + PG8_SB(b, h) + boff + n * 2048 + k * 1024); } while (0)
#define PG8_MMA(ai, bj, At, Bt) do { __builtin_amdgcn_s_setprio(1); _Pragma("unroll") for (int m = 0; m < 4; ++m) _Pragma("unroll") for (int n = 0; n < 2; ++n) _Pragma("unroll") for (int k = 0; k < 2; ++k) \
        acc[ai][bj][m][n] = __builtin_amdgcn_mfma_f32_16x16x32_bf16(Bt[n][k], At[m][k], acc[ai][bj][m][n], 0, 0, 0); __builtin_amdgcn_s_setprio(0); } while (0)
#define PG8_WAIT_V(n) asm volatile("s_waitcnt vmcnt(" #n ")" ::: "memory")
#define PG8_WAIT_L(n) asm volatile("s_waitcnt lgkmcnt(" #n ")" ::: "memory")
#define PG8_BAR __builtin_amdgcn_s_barrier()
#define PG8_SCHED __builtin_amdgcn_sched_barrier(0)
    Unit cur, nxt; int ui = 0;
    if (!S.next(0, cur)) return;
    f32x4 acc[2][2][4][2];
#pragma unroll
    for (int a = 0; a < 2; ++a)
#pragma unroll
        for (int b = 0; b < 2; ++b)
#pragma unroll
            for (int m = 0; m < 4; ++m)
#pragma unroll
                for (int n = 0; n < 2; ++n) acc[a][b][m][n] = (f32x4){0.f, 0.f, 0.f, 0.f};
    bf16x8 At[4][2], B0[2][2], B1[2][2];
    const char* cA = (const char*)g.A + (size_t)cur.pm * tstep; const char* cB = (const char*)g.Bt + (size_t)cur.pn * tstep;
    S.a_ready(cur);
    if constexpr (SP2) {
        PG8_STAGE(PG8_SB(0, 0), cB, voffB); PG8_STAGE(PG8_SB(0, 1), cB + hstep, voffB); PG8_STAGE(PG8_SA(0, 0), cA, voffA); PG8_STAGE(PG8_SA(0, 1), cA + hstep, voffA);
        if (wr == 1) PG8_BAR;
        PG8_WAIT_V(2); PG8_BAR;
        PG8_STAGE(PG8_SB(1, 0), cB + kstep, voffB); PG8_STAGE(PG8_SA(1, 0), cA + kstep, voffA); PG8_STAGE(PG8_SB(1, 1), cB + hstep + kstep, voffB);
        PG8_WAIT_V(6); PG8_BAR;
    } else {
        PG8_STAGE(PG8_SB(0, 0), cB, voffB); PG8_STAGE(PG8_SA(0, 0), cA, voffA); PG8_STAGE(PG8_SB(0, 1), cB + hstep, voffB); PG8_STAGE(PG8_SA(0, 1), cA + hstep, voffA);
        if (wr == 1) PG8_BAR;
        PG8_WAIT_V(4); PG8_BAR;
        PG8_STAGE(PG8_SB(1, 0), cB + kstep, voffB); PG8_STAGE(PG8_SA(1, 0), cA + kstep, voffA); PG8_STAGE(PG8_SB(1, 1), cB + hstep + kstep, voffB);
        PG8_WAIT_V(6); PG8_BAR;
    }
    for (;;) {
        const bool has_next = S.next(ui + 1, nxt);
        const char* nA = has_next ? (const char*)g.A + (size_t)nxt.pm * tstep : cA; const char* nB = has_next ? (const char*)g.Bt + (size_t)nxt.pn * tstep : cB;
        for (int t = 0; t < nt; t += 2) {
            const bool last = (t == nt - 2);
            const char* a1 = cA + (size_t)(t + 1) * kstep;
            const char* a2 = last ? nA : cA + (size_t)(t + 2) * kstep; const char* b2 = last ? nB : cB + (size_t)(t + 2) * kstep;
            const char* a3 = a2 + kstep; const char* b3 = b2 + kstep;
            if (last && has_next) S.a_ready(nxt);
            if constexpr (SP2) {
            PG8_LDB(B0, 0, 0); PG8_LDB(B1, 0, 1); PG8_SCHED; PG8_LDA(At, 0, 0); PG8_STAGE(PG8_SA(1, 1), a1 + hstep, voffA);
            PG8_WAIT_V(8); PG8_WAIT_L(0); PG8_BAR; PG8_MMA(0, 0, At, B0); PG8_MMA(0, 1, At, B1); PG8_BAR; PG8_SCHED;
            PG8_LDA(At, 0, 1); PG8_STAGE(PG8_SB(0, 0), b2, voffB); PG8_STAGE(PG8_SB(0, 1), b2 + hstep, voffB); PG8_STAGE(PG8_SA(0, 0), a2, voffA);
            PG8_WAIT_V(8); PG8_WAIT_L(0); PG8_BAR; PG8_MMA(1, 0, At, B0); PG8_MMA(1, 1, At, B1); PG8_BAR; PG8_SCHED;
            PG8_LDB(B0, 1, 0); PG8_LDB(B1, 1, 1); PG8_SCHED; PG8_LDA(At, 1, 0); PG8_STAGE(PG8_SA(0, 1), a2 + hstep, voffA);
            PG8_WAIT_V(8); PG8_WAIT_L(0); PG8_BAR; PG8_MMA(0, 0, At, B0); PG8_MMA(0, 1, At, B1); PG8_BAR; PG8_SCHED;
            PG8_LDA(At, 1, 1); PG8_STAGE(PG8_SB(1, 0), b3, voffB); PG8_STAGE(PG8_SB(1, 1), b3 + hstep, voffB); PG8_STAGE(PG8_SA(1, 0), a3, voffA);
            PG8_WAIT_V(8); PG8_WAIT_L(0); PG8_BAR; PG8_MMA(1, 0, At, B0); PG8_MMA(1, 1, At, B1); PG8_BAR; PG8_SCHED;
            } else {
            PG8_LDB(B0, 0, 0); PG8_SCHED; PG8_LDA(At, 0, 0); PG8_STAGE(PG8_SA(1, 1), a1 + hstep, voffA);
            PG8_WAIT_L(8); PG8_BAR; PG8_WAIT_L(0); PG8_MMA(0, 0, At, B0); PG8_BAR; PG8_SCHED;
            PG8_LDB(B1, 0, 1); PG8_STAGE(PG8_SB(0, 0), b2, voffB);
            PG8_BAR; PG8_WAIT_L(0); PG8_MMA(0, 1, At, B1); PG8_BAR;
            PG8_LDA(At, 0, 1); PG8_STAGE(PG8_SA(0, 0), a2, voffA);
            PG8_BAR; PG8_WAIT_L(0); PG8_MMA(1, 0, At, B0); PG8_BAR; PG8_SCHED;
            PG8_STAGE(PG8_SB(0, 1), b2 + hstep, voffB);
            PG8_WAIT_V(6); PG8_BAR; PG8_MMA(1, 1, At, B1); PG8_BAR;
            PG8_LDB(B0, 1, 0); PG8_SCHED; PG8_LDA(At, 1, 0); PG8_STAGE(PG8_SA(0, 1), a2 + hstep, voffA);
            PG8_WAIT_L(8); PG8_BAR; PG8_WAIT_L(0); PG8_MMA(0, 0, At, B0); PG8_BAR; PG8_SCHED;
            PG8_LDB(B1, 1, 1); PG8_STAGE(PG8_SB(1, 0), b3, voffB);
            PG8_BAR; PG8_WAIT_L(0); PG8_MMA(0, 1, At, B1); PG8_BAR;
            PG8_LDA(At, 1, 1); PG8_STAGE(PG8_SA(1, 0), a3, voffA);
            PG8_BAR; PG8_WAIT_L(0); PG8_MMA(1, 0, At, B0); PG8_BAR; PG8_SCHED;
            PG8_STAGE(PG8_SB(1, 1), b3 + hstep, voffB);
            PG8_WAIT_V(6); PG8_BAR; PG8_MMA(1, 1, At, B1); PG8_BAR;
            }
        }
        if constexpr (ALIGN_EPI) { if (wr == 0) PG8_BAR; }
        if constexpr (!Epi::AFTER_DRAIN) { E(acc, cur, wr, wc, fr, fq); S.done(cur); }
        if (!has_next) break;
#pragma unroll
        for (int a = 0; a < 2; ++a)
#pragma unroll
            for (int b = 0; b < 2; ++b)
#pragma unroll
                for (int m = 0; m < 4; ++m)
#pragma unroll
                    for (int n = 0; n < 2; ++n) acc[a][b][m][n] = (f32x4){0.f, 0.f, 0.f, 0.f};
        cur = nxt; cA = nA; cB = nB; ++ui;
        if constexpr (ALIGN_EPI) { if (wr == 1) PG8_BAR; }
    }
    PG8_WAIT_V(0);
    if constexpr (!ALIGN_EPI) { if (wr == 0) PG8_BAR; }
    PG8_BAR;
    if constexpr (Epi::AFTER_DRAIN) { E.fused(acc, cur, wr, wc, fr, fq, lds, wid, lane); S.done(cur); }
#undef PG8_SA
#undef PG8_SB
#undef PG8_STAGE
#undef PG8_LDA
#undef PG8_LDB
#undef PG8_MMA
#undef PG8_WAIT_V
#undef PG8_WAIT_L
#undef PG8_BAR
#undef PG8_SCHED
}
}

#ifndef MK_ONE_LAUNCH
#define MK_ONE_LAUNCH 1
#endif
typedef unsigned short bf16_t;
typedef short bf16x8 __attribute__((ext_vector_type(8)));
typedef float f32x4 __attribute__((ext_vector_type(4)));
typedef float f32x16 __attribute__((ext_vector_type(16)));
typedef unsigned u32x4 __attribute__((ext_vector_type(4)));
typedef unsigned u32x2 __attribute__((ext_vector_type(2)));

constexpr int NB = 8, SEQ = 8192, MTOK = NB * SEQ, DM = 1024, DFF = 2816, DEPTH = 2;
constexpr int NPROJ = 3840;
constexpr int INW = 3792;
constexpr float RMS_EPS = 1e-6f;
constexpr float LOG2E = 1.4426950408889634f;
constexpr float QSCALE = 0.125f * 1.4426950408889634f;
constexpr float IDX_SCALE = 0.35355339059327373f * 0.125f;
constexpr int AQ_OFF = 0, AK_OFF = 256, AV_OFF = 320, IQ_OFF = 384, IK_OFF = 896, BQ_OFF = 960, BK_OFF = 1216, BV_OFF = 1472,
              CQ_OFF = 1728, CK_OFF = 2240, CV_OFF = 2752, CG_OFF = 3264;
constexpr size_t MiB = 1u << 20;
constexpr size_t WS_CTL = 0, WS_COS = 1 * MiB, WS_SIN = 2 * MiB, WS_IW = 3 * MiB, WS_LF = 5 * MiB, WS_CUM = 7 * MiB, WS_KMEAN = 9 * MiB;
constexpr size_t WS_W = 10 * MiB;
constexpr size_t W_GU_BYTES = (size_t)2 * DFF * DM * 2, W_D_BYTES = (size_t)DM * DFF * 2, W_IN_BYTES = (size_t)NPROJ * DM * 2, W_OUT_BYTES = (size_t)DM * DM * 2;
constexpr size_t WL_GU1 = 0, WL_D1 = WL_GU1 + W_GU_BYTES, WL_GU2 = WL_D1 + W_D_BYTES, WL_D2 = WL_GU2 + W_GU_BYTES, WL_IN = WL_D2 + W_D_BYTES, WL_OUT = WL_IN + W_IN_BYTES,
                 WL_BYTES = WL_OUT + W_OUT_BYTES;
static_assert(WS_W + 2 * WL_BYTES <= 96 * MiB, "weights");
constexpr size_t WS_XN = 96 * MiB, WS_BIG = 224 * MiB, WS_SCR = 704 * MiB, WS_SS = 960 * MiB, WS_END = 984 * MiB;
constexpr size_t WS_HBB = WS_BIG + 352 * MiB;
constexpr size_t SS_STRIDE = (size_t)NB * SEQ * 4;
constexpr int LDS_BYTES = 147456, MISC_OFF = 131072;
constexpr int NTHREADS = 512;

struct Args { const float* in[19]; float* out; unsigned char* ws; int ph_lo, ph_hi; };

__device__ __forceinline__ float bf2f(unsigned short v) { return __uint_as_float((unsigned)v << 16); }
__device__ __forceinline__ unsigned pk2(float lo, float hi) { return pg8::cvt_pk_bf16(lo, hi); }
__device__ __forceinline__ float wave_sum(float v) {
#pragma unroll
    for (int o = 1; o < 64; o <<= 1) v += __shfl_xor(v, o);
    return v;
}
__device__ __forceinline__ float fexp2(float x) { return __builtin_amdgcn_exp2f(x); }
__device__ __forceinline__ float max3f(float a, float b, float c) { float r; asm("v_max3_f32 %0, %1, %2, %3" : "=v"(r) : "v"(a), "v"(b), "v"(c)); return r; }
__device__ __forceinline__ float max2f(float a, float b) { float r; asm("v_max_f32_e32 %0, %1, %2" : "=v"(r) : "v"(a), "v"(b)); return r; }
__device__ __forceinline__ f32x16 mfma32(bf16x8 a, bf16x8 b, f32x16 c) { return __builtin_amdgcn_mfma_f32_32x32x16_bf16(a, b, c, 0, 0, 0); }

__device__ __forceinline__ float row_rscale(const float* SSP, int row) {
    const f32x4* p = (const f32x4*)(SSP + (size_t)row * 16);
    const f32x4 a = p[0], b = p[1], c = p[2], d = p[3];
    const float s = ((a[0] + a[1]) + (a[2] + a[3])) + ((b[0] + b[1]) + (b[2] + b[3])) + ((c[0] + c[1]) + (c[2] + c[3])) + ((d[0] + d[1]) + (d[2] + d[3]));
    return 1.0f / sqrtf(s * (1.0f / DM) + RMS_EPS);
}
struct EpiSwiglu {
    static constexpr bool PERM = true, AFTER_DRAIN = false;
    bf16_t* O; const float* SS;
    __device__ __forceinline__ void operator()(const pg8::f32x4 (&acc)[2][2][4][2], const pg8::Unit& u, int wr, int wc, int fr, int fq) const {
        const int row0 = u.pm * 256 + wr * 64 + fr, col0 = u.pn * 128 + wc * 32 + 8 * fq;
#pragma unroll
        for (int ai = 0; ai < 2; ++ai)
#pragma unroll
            for (int m = 0; m < 4; ++m) {
                float y[8];
                const float rr = row_rscale(SS, row0 + ai * 128 + m * 16);
#pragma unroll
                for (int n = 0; n < 2; ++n)
#pragma unroll
                    for (int i = 0; i < 4; ++i) {
                        const float g = acc[ai][0][m][n][i] * rr, up = acc[ai][1][m][n][i] * rr;
                        const float sg = __builtin_amdgcn_rcpf(1.0f + fexp2(-g * LOG2E));
                        y[4 * n + i] = g * sg * up;
                    }
                u32x4 w; w.x = pk2(y[0], y[1]); w.y = pk2(y[2], y[3]); w.z = pk2(y[4], y[5]); w.w = pk2(y[6], y[7]);
                __builtin_nontemporal_store(w, (u32x4*)(O + (size_t)(row0 + ai * 128 + m * 16) * DFF + col0));
            }
    }
};
template <bool WHB, int ALPHA2>
struct EpiResid {
    static constexpr bool PERM = true, AFTER_DRAIN = false;
    const float* base; float* out; bf16_t* HB; float* SS;
    __device__ __forceinline__ void operator()(const pg8::f32x4 (&acc)[2][2][4][2], const pg8::Unit& u, int wr, int wc, int fr, int fq) const {
        constexpr float alpha = 0.5f * ALPHA2;
        const int row0 = u.pm * 256 + wr * 64 + fr, col0 = u.pn * 256 + wc * 32 + 8 * fq;
#pragma unroll
        for (int ai = 0; ai < 2; ++ai) {
            f32x4 pre[4][2][2];
#pragma unroll
            for (int m = 0; m < 4; ++m)
#pragma unroll
                for (int bj = 0; bj < 2; ++bj) {
                    const size_t ix = (size_t)(row0 + ai * 128 + m * 16) * DM + col0 + bj * 128;
                    pre[m][bj][0] = __builtin_nontemporal_load((const f32x4*)(base + ix)); pre[m][bj][1] = __builtin_nontemporal_load((const f32x4*)(base + ix + 4));
                }
#pragma unroll
            for (int m = 0; m < 4; ++m) {
                const int row = row0 + ai * 128 + m * 16;
                const size_t off = (size_t)row * DM + col0;
                float ssum = 0.f;
#pragma unroll
                for (int bj = 0; bj < 2; ++bj) {
                    const size_t ix = off + bj * 128;
                    const f32x4 b0 = pre[m][bj][0], b1 = pre[m][bj][1];
                    const f32x4 o0 = b0 + acc[ai][bj][m][0] * alpha, o1 = b1 + acc[ai][bj][m][1] * alpha;
                    __builtin_nontemporal_store(o0, (f32x4*)(out + ix)); __builtin_nontemporal_store(o1, (f32x4*)(out + ix + 4));
                    if (WHB) {
                        u32x4 w; w.x = pk2(o0[0], o0[1]); w.y = pk2(o0[2], o0[3]); w.z = pk2(o1[0], o1[1]); w.w = pk2(o1[2], o1[3]);
                        *(u32x4*)(HB + ix) = w;
                        ssum += (o0[0] * o0[0] + o0[1] * o0[1]) + (o0[2] * o0[2] + o0[3] * o0[3]) + (o1[0] * o1[0] + o1[1] * o1[1]) + (o1[2] * o1[2] + o1[3] * o1[3]);
                    }
                }
                if (WHB) {
                    ssum += __shfl_xor(ssum, 16); ssum += __shfl_xor(ssum, 32);
                    if (fq == 0) SS[(size_t)row * 16 + u.pn * 4 + wc] = ssum;
                }
            }
        }
    }
};
struct EpiProj {
    static constexpr bool PERM = true, AFTER_DRAIN = false;
    bf16_t* P; float* IW; float* LF; const float* cosT; const float* sinT;
    const float *gaq, *gak, *gbq, *gbk, *gcq, *gck, *fbias; const float* SS;
    __device__ __forceinline__ void operator()(const pg8::f32x4 (&acc)[2][2][4][2], const pg8::Unit& u, int wr, int wc, int fr, int fq) const {
        const int g = 4 * u.pn + wc;
        const int row0 = u.pm * 256 + wr * 64 + fr;
        if (g == 59) {
            if (fq < 2) {
#pragma unroll
                for (int ai = 0; ai < 2; ++ai)
#pragma unroll
                    for (int m = 0; m < 4; ++m) {
                        const int row = row0 + ai * 128 + m * 16;
                        const float rr = row_rscale(SS, row);
#pragma unroll
                        for (int n = 0; n < 2; ++n) {
                            f32x4 v = acc[ai][0][m][n] * rr;
                            if (fq == 1) {
#pragma unroll
                                for (int i = 0; i < 4; ++i) {
                                    const float x = v[i] + fbias[4 * n + i];
                                    const float ls = (x >= 0.f) ? -log1pf(expf(-x)) : (x - log1pf(expf(x)));
                                    v[i] = ls * LOG2E;
                                }
                                *(f32x4*)(LF + (size_t)row * 8 + 4 * n) = v;
                            } else {
                                *(f32x4*)(IW + (size_t)row * 8 + 4 * n) = v;
                            }
                        }
                    }
            }
            return;
        }
        int mode = 0; const float* gain = gaq;
        if (g < 4) { mode = 1 | 2 | 4; gain = gaq; }
        else if (g == 4) { mode = 1 | 2; gain = gak; }
        else if (g == 5) { mode = 0; }
        else if (g < 15) { mode = 2; }
        else if (g < 19) { mode = 1 | 2 | 4; gain = gbq; }
        else if (g < 23) { mode = 1 | 2; gain = gbk; }
        else if (g < 27) { mode = 0; }
        else if (g < 35) { mode = 1 | 4; gain = gcq; }
        else if (g < 43) { mode = 1; gain = gck; }
        else if (g < 51) { mode = 0; }
        else { mode = 8; }
        f32x4 gn[2][2];
#pragma unroll
        for (int bj = 0; bj < 2; ++bj)
#pragma unroll
            for (int n = 0; n < 2; ++n) gn[bj][n] = (mode & 1) ? *(const f32x4*)(gain + 32 * bj + 8 * fq + 4 * n) : (f32x4){1.f, 1.f, 1.f, 1.f};
        const float qs = (mode & 4) ? QSCALE : 1.0f;
#pragma unroll
        for (int ai = 0; ai < 2; ++ai)
#pragma unroll
            for (int m = 0; m < 4; ++m) {
                const int row = row0 + ai * 128 + m * 16;
                const float rr = row_rscale(SS, row);
                f32x4 v[2][2];
#pragma unroll
                for (int bj = 0; bj < 2; ++bj)
#pragma unroll
                    for (int n = 0; n < 2; ++n) v[bj][n] = acc[ai][bj][m][n] * rr;
                if (mode & 1) {
                    float ss = 0.f;
#pragma unroll
                    for (int bj = 0; bj < 2; ++bj)
#pragma unroll
                        for (int n = 0; n < 2; ++n) ss += (v[bj][n][0] * v[bj][n][0] + v[bj][n][1] * v[bj][n][1]) + (v[bj][n][2] * v[bj][n][2] + v[bj][n][3] * v[bj][n][3]);
                    ss += __shfl_xor(ss, 16); ss += __shfl_xor(ss, 32);
                    const float r = 1.0f / sqrtf(ss * (1.0f / 64.0f) + RMS_EPS);
#pragma unroll
                    for (int bj = 0; bj < 2; ++bj)
#pragma unroll
                        for (int n = 0; n < 2; ++n) v[bj][n] = v[bj][n] * r * gn[bj][n];
                }
                if (mode & 2) {
                    const int pos = row & (SEQ - 1);
#pragma unroll
                    for (int n = 0; n < 2; ++n) {
                        const f32x4 c = *(const f32x4*)(cosT + pos * 32 + 8 * fq + 4 * n), s = *(const f32x4*)(sinT + pos * 32 + 8 * fq + 4 * n);
                        const f32x4 x1 = v[0][n], x2 = v[1][n];
                        v[0][n] = x1 * c - x2 * s; v[1][n] = x2 * c + x1 * s;
                    }
                }
                if (mode & 8) {
#pragma unroll
                    for (int bj = 0; bj < 2; ++bj)
#pragma unroll
                        for (int n = 0; n < 2; ++n)
#pragma unroll
                            for (int i = 0; i < 4; ++i) v[bj][n][i] = 1.0f / (1.0f + __expf(-v[bj][n][i]));
                }
#pragma unroll
                for (int bj = 0; bj < 2; ++bj) {
                    const f32x4 a = v[bj][0] * qs, b = v[bj][1] * qs;
                    u32x4 w; w.x = pk2(a[0], a[1]); w.y = pk2(a[2], a[3]); w.z = pk2(b[0], b[1]); w.w = pk2(b[2], b[3]);
                    __builtin_nontemporal_store(w, (u32x4*)(P + (size_t)row * NPROJ + 64 * g + 32 * bj + 8 * fq));
                }
            }
    }
};

__device__ __forceinline__ int map_row(int kind, int n) {
    if (kind == 0) return n;
    if (kind == 1) return 256 * (n >> 7) + (n & 127);
    if (kind == 2) return 256 * (n >> 7) + 128 + (n & 127);
    int g, d;
    if (n < 384) { g = n >> 6; d = n & 63; }
    else if (n < 960) { g = 6 + ((n - 384) >> 6); d = (n - 384) & 63; }
    else if (n < 968) { g = 59; d = n - 960; }
    else if (n < 3272) { g = 15 + ((n - 968) >> 6); d = (n - 968) & 63; }
    else if (n < 3280) { g = 59; d = 8 + (n - 3272); }
    else { g = 51 + ((n - 3280) >> 6); d = (n - 3280) & 63; }
    return 256 * (g >> 2) + 128 * (d >> 5) + 32 * (g & 3) + (d & 31);
}
__device__ __forceinline__ void transpose_item(const float* W, const float* gain, int K, int N, bf16_t* WT, int kind, float* scr, int item, int lane) {
    const int nblk = (N + 31) / 32, kb = item / nblk, nb = item % nblk, k0 = 64 * kb, n0 = 32 * nb;
    const int n4 = 4 * (lane & 7), nc = n0 + n4;
#pragma unroll
    for (int i = 0; i < 8; ++i) {
        const int kk = 8 * i + (lane >> 3);
        f32x4 v = (nc < N) ? *(const f32x4*)(W + (size_t)(k0 + kk) * N + nc) : (f32x4){0.f, 0.f, 0.f, 0.f};
        if (gain) v = v * gain[k0 + kk];
        scr[kk * 33 + n4] = v[0]; scr[kk * 33 + n4 + 1] = v[1]; scr[kk * 33 + n4 + 2] = v[2]; scr[kk * 33 + n4 + 3] = v[3];
    }
    __builtin_amdgcn_fence(__ATOMIC_RELEASE, "wavefront"); __builtin_amdgcn_wave_barrier(); __builtin_amdgcn_fence(__ATOMIC_ACQUIRE, "wavefront");
    const int c = lane & 7;
#pragma unroll
    for (int j = 0; j < 4; ++j) {
        const int n = (lane >> 3) + 8 * j; const float* s = scr + (8 * c) * 33 + n;
        u32x4 o; o.x = pk2(s[0 * 33], s[1 * 33]); o.y = pk2(s[2 * 33], s[3 * 33]); o.z = pk2(s[4 * 33], s[5 * 33]); o.w = pk2(s[6 * 33], s[7 * 33]);
        if (n0 + n < N) *(u32x4*)(WT + (size_t)map_row(kind, n0 + n) * K + k0 + 8 * c) = o;
    }
    __builtin_amdgcn_fence(__ATOMIC_RELEASE, "wavefront"); __builtin_amdgcn_wave_barrier(); __builtin_amdgcn_fence(__ATOMIC_ACQUIRE, "wavefront");
}
__device__ __forceinline__ void cvt_row(const float* xrow, bf16_t* orow, float* ss, int lane) {
    const f32x4* xr = (const f32x4*)xrow + lane;
    f32x4 v[4]; float s = 0.f;
#pragma unroll
    for (int j = 0; j < 4; ++j) { v[j] = xr[64 * j]; s += (v[j][0] * v[j][0] + v[j][1] * v[j][1]) + (v[j][2] * v[j][2] + v[j][3] * v[j][3]); }
    s = wave_sum(s);
    u32x2* o8 = (u32x2*)orow + lane;
#pragma unroll
    for (int j = 0; j < 4; ++j) { u32x2 w; w.x = pk2(v[j][0], v[j][1]); w.y = pk2(v[j][2], v[j][3]); o8[64 * j] = w; }
    if (lane < 16) ss[lane] = (lane == 0) ? s : 0.f;
}

__device__ __forceinline__ void scan_kmean_phase(const float* LF, float* CUM, const bf16_t* P, float* KMEAN, char* lds) {
    const int tid = threadIdx.x, lane = tid & 63, wave = tid >> 6;
    double* sd = (double*)lds;
    for (int u = blockIdx.x; u < 64; u += gridDim.x) {
        const int b = u >> 3, hh = u & 7;
        const float* src = LF + ((size_t)b * SEQ + 16 * tid) * 8 + hh;
        double loc[16]; double run = 0.0;
#pragma unroll
        for (int e = 0; e < 16; ++e) { run += (double)src[e * 8]; loc[e] = run; }
        __syncthreads();
        sd[tid] = run;
        __syncthreads();
        for (int off = 1; off < 512; off <<= 1) {
            const double v = (tid >= off) ? sd[tid - off] : 0.0;
            __syncthreads();
            sd[tid] += v;
            __syncthreads();
        }
        const double base = (tid > 0) ? sd[tid - 1] : 0.0;
        float* dst = CUM + ((size_t)b * SEQ + 16 * tid) * 8 + hh;
#pragma unroll
        for (int e = 0; e < 16; ++e) dst[e * 8] = (float)(base + loc[e]);
        __syncthreads();
    }
    const bool split = gridDim.x >= 128;
    if (split && blockIdx.x < 64) return;
    const int gw = (split ? (int)blockIdx.x - 64 : (int)blockIdx.x) * 8 + wave, ngw = (split ? (int)gridDim.x - 64 : (int)gridDim.x) * 8;
    for (int u = gw; u < NB * 4 * 32; u += ngw) {
        const int b = u >> 7, h = (u >> 5) & 3, blk = u & 31;
        const bf16_t* src = P + ((size_t)b * SEQ + 256 * blk + (lane >> 3)) * NPROJ + BK_OFF + 64 * h + 8 * (lane & 7);
        float acc[8];
#pragma unroll
        for (int e = 0; e < 8; ++e) acc[e] = 0.f;
#pragma unroll 8
        for (int i = 0; i < 32; ++i) {
            const u32x4 v = *(const u32x4*)(src + (size_t)(8 * i) * NPROJ);
            acc[0] += __uint_as_float(v.x << 16); acc[1] += __uint_as_float(v.x & 0xffff0000u);
            acc[2] += __uint_as_float(v.y << 16); acc[3] += __uint_as_float(v.y & 0xffff0000u);
            acc[4] += __uint_as_float(v.z << 16); acc[5] += __uint_as_float(v.z & 0xffff0000u);
            acc[6] += __uint_as_float(v.w << 16); acc[7] += __uint_as_float(v.w & 0xffff0000u);
        }
#pragma unroll
        for (int e = 0; e < 8; ++e) { acc[e] += __shfl_xor(acc[e], 8); acc[e] += __shfl_xor(acc[e], 16); acc[e] += __shfl_xor(acc[e], 32); }
        if (lane < 8) {
            f32x4 o0v, o1v;
            o0v[0] = acc[0] * (1.0f / 256.0f); o0v[1] = acc[1] * (1.0f / 256.0f); o0v[2] = acc[2] * (1.0f / 256.0f); o0v[3] = acc[3] * (1.0f / 256.0f);
            o1v[0] = acc[4] * (1.0f / 256.0f); o1v[1] = acc[5] * (1.0f / 256.0f); o1v[2] = acc[6] * (1.0f / 256.0f); o1v[3] = acc[7] * (1.0f / 256.0f);
            *(f32x4*)(KMEAN + (size_t)u * 64 + 8 * lane) = o0v; *(f32x4*)(KMEAN + (size_t)u * 64 + 8 * lane + 4) = o1v;
        }
    }
}

constexpr int KS_LD = 72, VT_LD = 68;
constexpr int FL_KS = 0, FL_VT = FL_KS + 64 * KS_LD * 2, FL_CK = FL_VT + 64 * VT_LD * 2, FL_BUF = FL_CK + 256, FL_END = 2 * FL_BUF;
template <int MODE>
__device__ __forceinline__ void flash_unit(const bf16_t* __restrict__ P, const float* __restrict__ CUM, const float* __restrict__ KMEAN, bf16_t* __restrict__ MIX,
                                           const float* __restrict__ gq, const float* __restrict__ gk, int b, int h, int qt, char* lds) {
    int tid_ = threadIdx.x; asm volatile("" : "+v"(tid_));
    const int tid = tid_, lane = tid & 63, w = __builtin_amdgcn_readfirstlane(tid >> 6), l32 = lane & 31, hi = lane >> 5;
    constexpr int QOFF = MODE == 0 ? CQ_OFF : BQ_OFF, KOFF = MODE == 0 ? CK_OFF : BK_OFF, VOFF = MODE == 0 ? CV_OFF : BV_OFF, OOFF = MODE == 0 ? 512 : 256;
    unsigned* umask = (unsigned*)(lds + FL_END);
    const size_t rowbase = (size_t)b * SEQ;
    const int q0 = qt * 256 + w * 32, myq = q0 + l32;
    const bf16_t* qrow = P + (rowbase + myq) * NPROJ + QOFF + 64 * h;
    bf16x8 qf[4];
#pragma unroll
    for (int ks = 0; ks < 4; ++ks) qf[ks] = *(const bf16x8*)(qrow + 16 * ks + 8 * hi);
    unsigned selmask = 0, unionmask = 0xffffffffu;
    if (MODE == 1) {
        float v1 = -INFINITY, v2 = -INFINITY, v3 = -INFINITY; int i1 = -1, i2 = -1, i3 = -1;
        const float* km = KMEAN + ((size_t)(b * 4 + h) * 32) * 64;
        for (int n = 0; n < qt; ++n) {
            float gsum = 0.f;
#pragma unroll
            for (int c8 = 0; c8 < 8; ++c8) {
                const u32x4 qv = *(const u32x4*)(qrow + 8 * c8);
                const f32x4 k0 = *(const f32x4*)(km + n * 64 + 8 * c8), k1 = *(const f32x4*)(km + n * 64 + 8 * c8 + 4);
                gsum += __uint_as_float(qv.x << 16) * k0[0] + __uint_as_float(qv.x & 0xffff0000u) * k0[1] + __uint_as_float(qv.y << 16) * k0[2] + __uint_as_float(qv.y & 0xffff0000u) * k0[3]
                      + __uint_as_float(qv.z << 16) * k1[0] + __uint_as_float(qv.z & 0xffff0000u) * k1[1] + __uint_as_float(qv.w << 16) * k1[2] + __uint_as_float(qv.w & 0xffff0000u) * k1[3];
            }
            if (gsum > v3) {
                if (gsum > v1) { v3 = v2; i3 = i2; v2 = v1; i2 = i1; v1 = gsum; i1 = n; }
                else if (gsum > v2) { v3 = v2; i3 = i2; v2 = gsum; i2 = n; }
                else { v3 = gsum; i3 = n; }
            }
        }
        if (i1 >= 0) selmask |= 1u << i1;
        if (i2 >= 0) selmask |= 1u << i2;
        if (i3 >= 0) selmask |= 1u << i3;
        __syncthreads();
        if (tid == 0) *umask = 0u;
        __syncthreads();
        unsigned wm = selmask;
#pragma unroll
        for (int o = 1; o < 64; o <<= 1) wm |= __shfl_xor(wm, o);
        if (lane == 0) atomicOr(umask, wm);
        __syncthreads();
        unionmask = *umask;
    }
    float cref = 0.f;
    if (MODE == 0) cref = CUM[(rowbase + qt * 256) * 8 + h];
    float m = -INFINITY, lsum = 0.f;
    f32x16 o0, o1;
#pragma unroll
    for (int r = 0; r < 16; ++r) { o0[r] = 0.f; o1[r] = 0.f; }
    const int NT = 4 * qt + 4;
    const int kkey = tid >> 3, kch = tid & 7;
    const int vkey = 16 * (w & 3) + (lane & 15), vch = 4 * (w >> 2) + (lane >> 4);
    int kt = 0;
    if (MODE == 1) { while (kt < 4 * qt && !((unionmask >> (kt >> 2)) & 1u)) ++kt; }
    if (MODE == 0) {
        float gqm = fabsf(gq[lane]), gkm = fabsf(gk[lane]);
#pragma unroll
        for (int o = 1; o < 64; o <<= 1) { gqm = fmaxf(gqm, __shfl_xor(gqm, o)); gkm = fmaxf(gkm, __shfl_xor(gkm, o)); }
        const float margin = 2.0f * (64.0f * gqm * gkm * QSCALE * 1.02f) + 40.0f;
        bool skip = false;
        if (tid < 4 * qt) skip = (cref - CUM[(rowbase + 64 * tid + 63) * 8 + h]) < -margin;
        kt = __syncthreads_count(skip ? 1 : 0);
    }
    u32x4 kreg, vreg; float creg = 0.f;
#define FL_LOAD(kt_) do { kreg = *(const u32x4*)(P + (rowbase + 64 * (kt_) + kkey) * NPROJ + KOFF + 64 * h + 8 * kch); \
        vreg = *(const u32x4*)(P + (rowbase + 64 * (kt_) + vkey) * NPROJ + VOFF + 64 * h + 8 * vch); \
        if (MODE == 0 && tid < 64) creg = cref - CUM[(rowbase + 64 * (kt_) + tid) * 8 + h]; } while (0)
#define FL_STORE(buf_) do { bf16_t* Kd_ = (bf16_t*)(lds + (buf_) * FL_BUF + FL_KS); bf16_t* Vd_ = (bf16_t*)(lds + (buf_) * FL_BUF + FL_VT); \
        *(u32x4*)(Kd_ + kkey * KS_LD + 8 * kch) = kreg; \
        bf16_t* vd = Vd_ + (8 * vch) * VT_LD + vkey; \
        vd[0 * VT_LD] = (bf16_t)(vreg.x & 0xffffu); vd[1 * VT_LD] = (bf16_t)(vreg.x >> 16); \
        vd[2 * VT_LD] = (bf16_t)(vreg.y & 0xffffu); vd[3 * VT_LD] = (bf16_t)(vreg.y >> 16); \
        vd[4 * VT_LD] = (bf16_t)(vreg.z & 0xffffu); vd[5 * VT_LD] = (bf16_t)(vreg.z >> 16); \
        vd[6 * VT_LD] = (bf16_t)(vreg.w & 0xffffu); vd[7 * VT_LD] = (bf16_t)(vreg.w >> 16); \
        if (MODE == 0 && tid < 64) ((float*)(lds + (buf_) * FL_BUF + FL_CK))[tid] = creg; } while (0)
    FL_LOAD(kt);
    __syncthreads();
    FL_STORE(0);
    __syncthreads();
    int cur = 0;
    while (kt < NT) {
        const int ktc = kt;
        int ktn = kt + 1;
        if (MODE == 1) { while (ktn < 4 * qt && !((unionmask >> (ktn >> 2)) & 1u)) ++ktn; }
        if (ktn < NT) FL_LOAD(ktn);
        kt = ktn;
        const bf16_t* Ks = (const bf16_t*)(lds + cur * FL_BUF + FL_KS); const bf16_t* VT = (const bf16_t*)(lds + cur * FL_BUF + FL_VT);
        const float* cks = (const float*)(lds + cur * FL_BUF + FL_CK);
        if (!(64 * ktc > q0 + 31)) {
        f32x16 s0, s1;
#pragma unroll
        for (int r = 0; r < 16; ++r) { s0[r] = 0.f; s1[r] = 0.f; }
#pragma unroll
        for (int ks = 0; ks < 4; ++ks) {
            const bf16x8 a0 = *(const bf16x8*)(Ks + l32 * KS_LD + 16 * ks + 8 * hi);
            const bf16x8 a1 = *(const bf16x8*)(Ks + (32 + l32) * KS_LD + 16 * ks + 8 * hi);
            s0 = mfma32(a0, qf[ks], s0); s1 = mfma32(a1, qf[ks], s1);
        }
        if (MODE == 0) {
#pragma unroll
            for (int g = 0; g < 4; ++g) {
                const f32x4 c0 = *(const f32x4*)(cks + 8 * g + 4 * hi), c1 = *(const f32x4*)(cks + 32 + 8 * g + 4 * hi);
#pragma unroll
                for (int i = 0; i < 4; ++i) { s0[4 * g + i] += c0[i]; s1[4 * g + i] += c1[i]; }
            }
        }
        if (MODE == 1 && ktc < 4 * qt) {
            if (!((selmask >> (ktc >> 2)) & 1u)) {
#pragma unroll
                for (int r = 0; r < 16; ++r) { s0[r] = -INFINITY; s1[r] = -INFINITY; }
            }
        }
        if (64 * ktc + 63 > q0) {
#pragma unroll
            for (int r = 0; r < 16; ++r) {
                const int kg = 64 * ktc + 8 * (r >> 2) + 4 * hi + (r & 3);
                if (kg > myq) s0[r] = -INFINITY;
                if (kg + 32 > myq) s1[r] = -INFINITY;
            }
        }
        float mxa = max3f(s0[0], s0[1], s0[2]), mxb = max3f(s1[0], s1[1], s1[2]);
#pragma unroll
        for (int r = 3; r < 15; r += 2) { mxa = max3f(mxa, s0[r], s0[r + 1]); mxb = max3f(mxb, s1[r], s1[r + 1]); }
        float mx = max3f(mxa, mxb, s0[15]); mx = max2f(mx, s1[15]);
        mx = max2f(mx, __shfl_xor(mx, 32));
        const float mnew = max2f(m, mx);
        const float msafe = (mnew == -INFINITY) ? 0.f : mnew;
        const float alpha = fexp2(m - msafe);
        float psum = 0.f;
#pragma unroll
        for (int r = 0; r < 16; ++r) { s0[r] = fexp2(s0[r] - msafe); s1[r] = fexp2(s1[r] - msafe); psum += s0[r] + s1[r]; }
        lsum = lsum * alpha + psum; m = mnew;
#pragma unroll
        for (int r = 0; r < 16; ++r) { o0[r] *= alpha; o1[r] *= alpha; }
        bf16x8 pk[4];
        {
            u32x4 t;
            t.x = pk2(s0[0], s0[1]); t.y = pk2(s0[2], s0[3]); t.z = pk2(s0[4], s0[5]); t.w = pk2(s0[6], s0[7]); pk[0] = __builtin_bit_cast(bf16x8, t);
            t.x = pk2(s0[8], s0[9]); t.y = pk2(s0[10], s0[11]); t.z = pk2(s0[12], s0[13]); t.w = pk2(s0[14], s0[15]); pk[1] = __builtin_bit_cast(bf16x8, t);
            t.x = pk2(s1[0], s1[1]); t.y = pk2(s1[2], s1[3]); t.z = pk2(s1[4], s1[5]); t.w = pk2(s1[6], s1[7]); pk[2] = __builtin_bit_cast(bf16x8, t);
            t.x = pk2(s1[8], s1[9]); t.y = pk2(s1[10], s1[11]); t.z = pk2(s1[12], s1[13]); t.w = pk2(s1[14], s1[15]); pk[3] = __builtin_bit_cast(bf16x8, t);
        }
#pragma unroll
        for (int kk = 0; kk < 4; ++kk) {
            u32x4 a, c;
            const u32x2 a_lo = *(const u32x2*)(VT + l32 * VT_LD + 16 * kk + 4 * hi), a_hi = *(const u32x2*)(VT + l32 * VT_LD + 16 * kk + 8 + 4 * hi);
            const u32x2 c_lo = *(const u32x2*)(VT + (32 + l32) * VT_LD + 16 * kk + 4 * hi), c_hi = *(const u32x2*)(VT + (32 + l32) * VT_LD + 16 * kk + 8 + 4 * hi);
            a.x = a_lo.x; a.y = a_lo.y; a.z = a_hi.x; a.w = a_hi.y; c.x = c_lo.x; c.y = c_lo.y; c.z = c_hi.x; c.w = c_hi.y;
            o0 = mfma32(__builtin_bit_cast(bf16x8, a), pk[kk], o0);
            o1 = mfma32(__builtin_bit_cast(bf16x8, c), pk[kk], o1);
        }
        }
        if (kt < NT) FL_STORE(cur ^ 1);
        __syncthreads();
        cur ^= 1;
    }
#undef FL_LOAD
#undef FL_STORE
    const float ltot = lsum + __shfl_xor(lsum, 32);
    const float inv = 1.0f / ltot;
    bf16_t* orow = MIX + (rowbase + myq) * DM + OOFF + 64 * h;
    const bf16_t* grow = P + (rowbase + myq) * NPROJ + CG_OFF + 64 * h;
#pragma unroll
    for (int g = 0; g < 4; ++g) {
        const int d = 8 * g + 4 * hi;
        float a0 = o0[4 * g] * inv, a1 = o0[4 * g + 1] * inv, a2 = o0[4 * g + 2] * inv, a3 = o0[4 * g + 3] * inv;
        float c0 = o1[4 * g] * inv, c1 = o1[4 * g + 1] * inv, c2 = o1[4 * g + 2] * inv, c3 = o1[4 * g + 3] * inv;
        if (MODE == 0) {
            const u32x2 ga = *(const u32x2*)(grow + d), gc = *(const u32x2*)(grow + 32 + d);
            a0 *= __uint_as_float(ga.x << 16); a1 *= __uint_as_float(ga.x & 0xffff0000u); a2 *= __uint_as_float(ga.y << 16); a3 *= __uint_as_float(ga.y & 0xffff0000u);
            c0 *= __uint_as_float(gc.x << 16); c1 *= __uint_as_float(gc.x & 0xffff0000u); c2 *= __uint_as_float(gc.y << 16); c3 *= __uint_as_float(gc.y & 0xffff0000u);
        }
        u32x2 wa, wc2; wa.x = pk2(a0, a1); wa.y = pk2(a2, a3); wc2.x = pk2(c0, c1); wc2.y = pk2(c2, c3);
        *(u32x2*)(orow + d) = wa; *(u32x2*)(orow + 32 + d) = wc2;
    }
    __syncthreads();
}

constexpr int KI_LD = 72;
constexpr int VTD_LD = 72, PW_LD = 256;
constexpr int SEL_CAP = 512, CMP_CAP = 768;
constexpr int DS_KI = 0, DS_VT = 0, DS_LIST = 8 * 64 * VTD_LD * 2, DS_PW = DS_LIST + 8 * 512, DS_CK = DS_PW + 8 * 4 * PW_LD * 2, DS_CI = DS_CK + 8 * CMP_CAP * 4, DS_END = DS_CI + 8 * CMP_CAP * 2;
static_assert(512 * KI_LD * 2 <= DS_LIST && DS_END <= 131072, "DSA LDS map");
typedef short v4i16_t __attribute__((ext_vector_type(4)));
__device__ __forceinline__ v4i16_t ds_tr16(const void* p) { return __builtin_amdgcn_ds_read_tr16_b64_v4i16((__attribute__((address_space(3))) v4i16_t*)p); }
__device__ __forceinline__ void dsa_unit(const bf16_t* __restrict__ P, const float* __restrict__ IW, bf16_t* __restrict__ MIX, float* __restrict__ scr, int b, int tile, char* lds) {
    int tid_ = threadIdx.x; asm volatile("" : "+v"(tid_));
    const int tid = tid_, lane = tid & 63, w = __builtin_amdgcn_readfirstlane(tid >> 6), l32 = lane & 31, hi = lane >> 5;
    bf16_t* KI = (bf16_t*)(lds + DS_KI);
    unsigned short* LIST = (unsigned short*)(lds + DS_LIST) + w * 256;
    bf16_t* PWb = (bf16_t*)(lds + DS_PW) + w * 4 * PW_LD;
    bf16_t* Vt = (bf16_t*)(lds + DS_VT) + w * 64 * VTD_LD;
    unsigned* CK = (unsigned*)(lds + DS_CK) + w * CMP_CAP; unsigned short* CI = (unsigned short*)(lds + DS_CI) + w * CMP_CAP;
    const size_t rowbase = (size_t)b * SEQ;
    const int t0 = 32 * tile;
#ifdef PROBE_SCORE2
#pragma unroll 1
    for (int rep_ = 0; rep_ < 2; ++rep_)
#endif
    {
        const int qsel = ((l32 >> 4) & 1) + 2 * ((l32 >> 2) & 1), head = (l32 & 3) + 4 * ((l32 >> 3) & 1);
        const bf16_t* arow = P + (rowbase + t0 + 4 * w + qsel) * NPROJ + IQ_OFF + 64 * head + 8 * hi;
        bf16x8 af[4];
#pragma unroll
        for (int ks = 0; ks < 4; ++ks) af[ks] = *(const bf16x8*)(arow + 16 * ks);
        float wA[8], wB[8];
        {
            const float* wa = IW + (rowbase + t0 + 4 * w + 2 * hi) * 8;
#pragma unroll
            for (int hh = 0; hh < 8; ++hh) { wA[hh] = wa[hh] * IDX_SCALE; wB[hh] = wa[8 + hh] * IDX_SCALE; }
        }
        const int nkt = tile + 1, nchunk = (nkt + 15) >> 4;
        float* sA = scr + (size_t)(4 * w + 2 * hi) * SEQ; float* sB = sA + SEQ;
        u32x4 stg[8];
        const bf16_t* kisrc = P + (rowbase + (tid >> 3)) * NPROJ + IK_OFF + 8 * (tid & 7);
#pragma unroll
        for (int i8 = 0; i8 < 8; ++i8) stg[i8] = *(const u32x4*)(kisrc + (size_t)(64 * i8) * NPROJ);
#pragma unroll 1
        for (int c = 0; c < nchunk; ++c) {
            __syncthreads();
#pragma unroll
            for (int i8 = 0; i8 < 8; ++i8) *(u32x4*)(KI + ((tid >> 3) + 64 * i8) * KI_LD + 8 * (tid & 7)) = stg[i8];
            __syncthreads();
            if (c + 1 < nchunk) {
#pragma unroll
                for (int i8 = 0; i8 < 8; ++i8) stg[i8] = *(const u32x4*)(kisrc + (size_t)(512 * (c + 1) + 64 * i8) * NPROJ);
            }
            const int ntl = (nkt - 16 * c) < 16 ? (nkt - 16 * c) : 16;
#define SCORE_MMA(D_, k8_) do { _Pragma("unroll") for (int r_ = 0; r_ < 16; ++r_) D_[r_] = 0.f; \
                _Pragma("unroll") for (int ks_ = 0; ks_ < 4; ++ks_) D_ = mfma32(af[ks_], *(const bf16x8*)(KI + (32 * (k8_) + l32) * KI_LD + 16 * ks_ + 8 * hi), D_); } while (0)
#define SCORE_OUT(D_, k8_) do { float a_ = 0.f, b_ = 0.f; \
                _Pragma("unroll") for (int hh_ = 0; hh_ < 8; ++hh_) { a_ = __builtin_fmaf(wA[hh_], __builtin_amdgcn_fmed3f(D_[hh_], 0.f, __builtin_inff()), a_); \
                                                                     b_ = __builtin_fmaf(wB[hh_], __builtin_amdgcn_fmed3f(D_[8 + hh_], 0.f, __builtin_inff()), b_); } \
                const int key_ = 512 * c + 32 * (k8_) + l32; \
                const int ba_ = (int)__float_as_uint(a_ + 0.0f), bb_ = (int)__float_as_uint(b_ + 0.0f); \
                __builtin_nontemporal_store(__uint_as_float((unsigned)ba_ ^ ((unsigned)(ba_ >> 31) | 0x80000000u)), sA + key_); \
                __builtin_nontemporal_store(__uint_as_float((unsigned)bb_ ^ ((unsigned)(bb_ >> 31) | 0x80000000u)), sB + key_); } while (0)
            int k8 = 0;
#pragma unroll 1
            for (; k8 + 3 < ntl; k8 += 4) {
                f32x16 D0, D1, D2, D3;
                SCORE_MMA(D0, k8); SCORE_MMA(D1, k8 + 1); SCORE_MMA(D2, k8 + 2); SCORE_MMA(D3, k8 + 3);
                SCORE_OUT(D0, k8); SCORE_OUT(D1, k8 + 1); SCORE_OUT(D2, k8 + 2); SCORE_OUT(D3, k8 + 3);
            }
#pragma unroll 1
            for (; k8 < ntl; ++k8) { f32x16 D0; SCORE_MMA(D0, k8); SCORE_OUT(D0, k8); }
#undef SCORE_MMA
#undef SCORE_OUT
        }
    }
    __syncthreads();
    __builtin_amdgcn_fence(__ATOMIC_ACQUIRE, "agent");
    int eg = 127;
#pragma unroll 1
    for (int qq = 0; qq < 4; ++qq) {
        const int t = t0 + 4 * w + qq, n = t + 1;
        const size_t row = rowbase + t;
        int lane = threadIdx.x & 63; asm volatile("" : "+v"(lane));
        const float* srow = scr + (size_t)(4 * w + qq) * SEQ + lane;
        asm volatile("" : "+v"(srow));
        int cnt;
        if (n <= 256) {
            cnt = n;
            for (int j = lane; j < n; j += 64) LIST[j] = (unsigned short)j;
        } else {
            cnt = 256;
            unsigned v[128];
#pragma unroll
            for (int g = 0; g < 8; ++g) {
                if ((g + 1) * 1024 <= n) {
#pragma unroll
                    for (int jj = 0; jj < 16; ++jj) v[g * 16 + jj] = __float_as_uint(__builtin_nontemporal_load(srow + (g * 16 + jj) * 64));
                    asm volatile("" ::: "memory");
                } else if (g * 1024 < n) {
                    int lb = lane; asm volatile("" : "+v"(lb));
#pragma unroll
                    for (int jj = 0; jj < 16; ++jj) {
                        const int idx = (g * 16 + jj) * 64 + lb;
                        v[g * 16 + jj] = (idx < n) ? __float_as_uint(__builtin_nontemporal_load(srow + (g * 16 + jj) * 64)) : 0u;
                    }
                    asm volatile("" ::: "memory");
                } else {
#pragma unroll
                    for (int jj = 0; jj < 16; ++jj) v[g * 16 + jj] = 0u;
                }
            }
            unsigned T = 0u; int cT = n, cU = 0; int bit = 31; bool exact = false;
            if (n > 1024) {
                unsigned probe = 0x80000000u | ((unsigned)eg << 23);
                int cp = 0;
#pragma unroll
                for (int g = 0; g < 8; ++g) {
                    if (g * 1024 < n) {
#pragma unroll
                        for (int jj = 0; jj < 16; ++jj) cp += __builtin_popcountll(__ballot(v[g * 16 + jj] >= probe));
                    }
                }
                const bool up = cp >= 256;
#pragma unroll 1
                for (int tr = 0; tr < 3; ++tr) {
                    const unsigned p2 = up ? probe + (1u << 23) : probe - (1u << 23);
                    int c2 = 0;
#pragma unroll
                    for (int g = 0; g < 8; ++g) {
                        if (g * 1024 < n) {
#pragma unroll
                            for (int jj = 0; jj < 16; ++jj) c2 += __builtin_popcountll(__ballot(v[g * 16 + jj] >= p2));
                        }
                    }
                    if (up ? (c2 < 256) : (c2 >= 256)) {
                        T = up ? probe : p2; cT = up ? cp : c2; cU = up ? c2 : cp; bit = 22;
                        if (cT == 256) exact = true;
                        break;
                    }
                    probe = p2; cp = c2;
                }
            }
#pragma unroll 1
            while (!exact && bit >= 0 && (cT - cU) > SEL_CAP) {
                const unsigned cand = T | (1u << bit);
                int c = 0;
#pragma unroll
                for (int g = 0; g < 8; ++g) {
                    if (g * 1024 < n) {
#pragma unroll
                        for (int jj = 0; jj < 16; ++jj) c += __builtin_popcountll(__ballot(v[g * 16 + jj] >= cand));
                    }
                }
                --bit;
                if (c >= 256) { T = cand; cT = c; if (c == 256) { exact = true; break; } }
                else { cU = c; }
            }
            if (exact) {
                int pos = 0;
#pragma unroll
                for (int g = 0; g < 8; ++g) {
                    if (g * 1024 < n) {
                        int lb = lane; asm volatile("" : "+v"(lb));
#pragma unroll
                        for (int jj = 0; jj < 16; ++jj) {
                            const unsigned x = v[g * 16 + jj]; const int idx = (g * 16 + jj) * 64 + lb;
                            const bool gt = x >= T; const unsigned long long mg = __ballot(gt);
                            const int pre = __builtin_amdgcn_mbcnt_hi((unsigned)(mg >> 32), __builtin_amdgcn_mbcnt_lo((unsigned)mg, 0u));
                            if (gt) LIST[pos + pre] = (unsigned short)idx;
                            pos += __builtin_popcountll(mg);
                        }
                    }
                }
            } else {
                int bpos = 0;
                const unsigned Tb = T ? T : 1u;
                if (cT <= CMP_CAP) {
#pragma unroll
                for (int g = 0; g < 8; ++g) {
                    if (g * 1024 < n) {
                        int lb = lane; asm volatile("" : "+v"(lb));
#pragma unroll
                        for (int jj = 0; jj < 16; ++jj) {
                            const unsigned x = v[g * 16 + jj]; const int idx = (g * 16 + jj) * 64 + lb;
                            const bool inb = (x >= Tb); const unsigned long long mb = __ballot(inb);
                            const int pb = __builtin_amdgcn_mbcnt_hi((unsigned)(mb >> 32), __builtin_amdgcn_mbcnt_lo((unsigned)mb, 0u));
                            if (inb) { CK[bpos + pb] = x; CI[bpos + pb] = (unsigned short)idx; }
                            bpos += __builtin_popcountll(mb);
                        }
                    }
                }
                } else {
#pragma unroll
                for (int g = 0; g < 8; ++g) {
                    if (g * 1024 < n) {
                        int lb = lane; asm volatile("" : "+v"(lb));
#pragma unroll
                        for (int jj = 0; jj < 16; ++jj) {
                            const unsigned x = v[g * 16 + jj]; const int idx = (g * 16 + jj) * 64 + lb;
                            const bool inb = (x >= Tb); const unsigned long long mb = __ballot(inb);
                            const int pb = __builtin_amdgcn_mbcnt_hi((unsigned)(mb >> 32), __builtin_amdgcn_mbcnt_lo((unsigned)mb, 0u));
                            if (inb && (bpos + pb) < CMP_CAP) { CK[bpos + pb] = x; CI[bpos + pb] = (unsigned short)idx; }
                            bpos += __builtin_popcountll(mb);
                        }
                    }
                }
                }
                asm volatile("s_waitcnt lgkmcnt(0)" ::: "memory");
                __builtin_amdgcn_wave_barrier();
                const int mall = cT < CMP_CAP ? cT : CMP_CAP;
                unsigned cv[CMP_CAP / 64];
#pragma unroll
                for (int e = 0; e < CMP_CAP / 64; ++e) { const int p = e * 64 + lane; cv[e] = (p < mall) ? CK[p] : 0u; }
                bool exact2 = false;
#pragma unroll 1
                for (; bit >= 0; --bit) {
                    const unsigned cand = T | (1u << bit);
                    int c = 0;
#pragma unroll
                    for (int e = 0; e < CMP_CAP / 64; ++e) c += __builtin_popcountll(__ballot(cv[e] >= cand));
                    if (c >= 256) { T = cand; if (c == 256) { exact2 = true; break; } }
                }
                const unsigned Tg = exact2 ? (T - 1u) : T;
                int Gb = 0;
#pragma unroll
                for (int e = 0; e < CMP_CAP / 64; ++e) Gb += __builtin_popcountll(__ballot(cv[e] > Tg));
                const int E = exact2 ? 0 : (256 - Gb);
                int gpos = 0, eqseen = 0;
#pragma unroll
                for (int e = 0; e < CMP_CAP / 64; ++e) {
                    const int p = e * 64 + lane; const unsigned x = cv[e];
                    const unsigned short ci = CI[p < mall ? p : 0];
                    const bool gt = x > Tg; const unsigned long long mg = __ballot(gt);
                    const int pre = __builtin_amdgcn_mbcnt_hi((unsigned)(mg >> 32), __builtin_amdgcn_mbcnt_lo((unsigned)mg, 0u));
                    if (gt) LIST[gpos + pre] = ci;
                    gpos += __builtin_popcountll(mg);
                    const bool eq = (!exact2) && (x == T) && (p < mall); const unsigned long long me = __ballot(eq);
                    const int pe = __builtin_amdgcn_mbcnt_hi((unsigned)(me >> 32), __builtin_amdgcn_mbcnt_lo((unsigned)me, 0u));
                    if (eq && (eqseen + pe) < E) LIST[Gb + eqseen + pe] = ci;
                    eqseen += __builtin_popcountll(me);
                }
            }
            if (T >= 0x80800000u) { const int e_ = (int)((T >> 23) & 0xffu); eg = e_ < 4 ? 4 : (e_ > 250 ? 250 : e_); }
        }
        __builtin_amdgcn_fence(__ATOMIC_RELEASE, "wavefront"); __builtin_amdgcn_wave_barrier(); __builtin_amdgcn_fence(__ATOMIC_ACQUIRE, "wavefront");
#ifdef PROBE_ATTN2
#pragma unroll 1
        for (int rep_ = 0; rep_ < 2; ++rep_) {
#else
        {
#endif
        int ln = lane; asm volatile("" : "+v"(ln));
        const int l32a = ln & 31, hia = ln >> 5;
        bf16x8 aq[4];
        {
            const bf16_t* qr = P + row * NPROJ + AQ_OFF + 64 * (l32a & 3) + 8 * hia;
#pragma unroll
            for (int ks = 0; ks < 4; ++ks) {
                bf16x8 z = *(const bf16x8*)(qr + 16 * ks);
                if (l32a >= 4) z = (bf16x8){0, 0, 0, 0, 0, 0, 0, 0};
                aq[ks] = z;
            }
        }
        const bf16_t* kbase = P + rowbase * NPROJ + AK_OFF + 8 * hia;
        const bf16_t* vgbase = P + rowbase * NPROJ + AV_OFF + 8 * (ln & 7);
        u32x4 vr[8];
#define DSA_VLOAD(vt) do { _Pragma("unroll") for (int i_ = 0; i_ < 8; ++i_) { const int j_ = 64 * (vt) + 8 * i_ + (ln >> 3); \
            const int idx_ = (j_ < cnt) ? (int)LIST[j_] : 0; vr[i_] = *(const u32x4*)(vgbase + (size_t)idx_ * NPROJ); } } while (0)
        DSA_VLOAD(0);
        float sc[8][4];
        const int ntile = (cnt + 31) >> 5;
#pragma unroll
        for (int grp = 0; grp < 2; ++grp) {
            if (grp * 4 < ntile) {
                bf16x8 kb[4][4];
#pragma unroll
                for (int k4 = 0; k4 < 4; ++k4) {
                    const int j = 32 * (4 * grp + k4) + l32a;
                    const int idx = (j < cnt) ? (int)LIST[j] : 0;
                    const bf16_t* kr = kbase + (size_t)idx * NPROJ;
#pragma unroll
                    for (int ks = 0; ks < 4; ++ks) kb[k4][ks] = *(const bf16x8*)(kr + 16 * ks);
                }
#pragma unroll
                for (int k4 = 0; k4 < 4; ++k4) {
                    const int j = 32 * (4 * grp + k4) + l32a;
                    f32x16 D;
#pragma unroll
                    for (int r = 0; r < 16; ++r) D[r] = 0.f;
#pragma unroll
                    for (int ks = 0; ks < 4; ++ks) D = mfma32(aq[ks], kb[k4][ks], D);
                    const bool ok = (j < cnt) && (hia == 0);
#pragma unroll
                    for (int hh = 0; hh < 4; ++hh) sc[4 * grp + k4][hh] = ok ? D[hh] : -INFINITY;
                }
            } else {
#pragma unroll
                for (int k4 = 0; k4 < 4; ++k4)
#pragma unroll
                    for (int hh = 0; hh < 4; ++hh) sc[4 * grp + k4][hh] = -INFINITY;
            }
        }
        float lh[4];
#pragma unroll
        for (int hh = 0; hh < 4; ++hh) {
            float mx = sc[0][hh];
#pragma unroll
            for (int kt = 1; kt < 8; ++kt) mx = fmaxf(mx, sc[kt][hh]);
#pragma unroll
            for (int o = 1; o < 32; o <<= 1) mx = fmaxf(mx, __shfl_xor(mx, o));
            const float ms = (mx == -INFINITY) ? 0.f : mx;
            float sm = 0.f;
#pragma unroll
            for (int kt = 0; kt < 8; ++kt) { sc[kt][hh] = fexp2(sc[kt][hh] - ms); sm += sc[kt][hh]; }
#pragma unroll
            for (int o = 1; o < 32; o <<= 1) sm += __shfl_xor(sm, o);
            sm += __shfl_xor(sm, 32);
            lh[hh] = sm;
        }
        if (hia == 0) {
#pragma unroll
            for (int hh = 0; hh < 4; ++hh)
#pragma unroll
                for (int kt = 0; kt < 8; ++kt) PWb[hh * PW_LD + 32 * kt + l32a] = (bf16_t)(pk2(sc[kt][hh], 0.f) & 0xffffu);
        }
        asm volatile("s_waitcnt lgkmcnt(0)" ::: "memory");
        __builtin_amdgcn_wave_barrier();
        f32x16 oA, oB;
#pragma unroll
        for (int r = 0; r < 16; ++r) { oA[r] = 0.f; oB[r] = 0.f; }
        const int nvt = (cnt + 63) >> 6;
        const int tq = (ln & 15) >> 2, tp = ln & 3, tc = (ln >> 4) & 1;
#pragma unroll 1
        for (int vt = 0; vt < nvt; ++vt) {
#pragma unroll
            for (int i = 0; i < 8; ++i) *(u32x4*)(Vt + (8 * i + (ln >> 3)) * VTD_LD + 8 * (ln & 7)) = vr[i];
            asm volatile("s_waitcnt lgkmcnt(0)" ::: "memory");
            __builtin_amdgcn_wave_barrier();
            if (vt + 1 < nvt) DSA_VLOAD(vt + 1);
            const bf16_t* vtl = Vt + (8 * hia + tq) * VTD_LD + 16 * tc + 4 * tp;
            asm volatile("" : "+v"(vtl));
#pragma unroll
            for (int ks = 0; ks < 4; ++ks) {
                bf16x8 ap = *(const bf16x8*)(PWb + (l32a & 3) * PW_LD + 64 * vt + 16 * ks + 8 * hia);
                if (l32a >= 4) ap = (bf16x8){0, 0, 0, 0, 0, 0, 0, 0};
                const bf16_t* vrow = vtl + (16 * ks) * VTD_LD;
                const v4i16_t r1 = ds_tr16(vrow), r2 = ds_tr16(vrow + 4 * VTD_LD);
                const v4i16_t r3 = ds_tr16(vrow + 32), r4 = ds_tr16(vrow + 4 * VTD_LD + 32);
                const bf16x8 b0 = (bf16x8){r1[0], r1[1], r1[2], r1[3], r2[0], r2[1], r2[2], r2[3]};
                const bf16x8 b1 = (bf16x8){r3[0], r3[1], r3[2], r3[3], r4[0], r4[1], r4[2], r4[3]};
                oA = mfma32(ap, b0, oA); oB = mfma32(ap, b1, oB);
            }
            asm volatile("" : "+v"(oA), "+v"(oB));
            asm volatile("s_waitcnt lgkmcnt(0)" ::: "memory");
            __builtin_amdgcn_wave_barrier();
        }
#undef DSA_VLOAD
        if (hia == 0) {
            bf16_t* orow = MIX + row * DM + l32a;
#pragma unroll
            for (int hh = 0; hh < 4; ++hh) {
                const float il = 1.0f / lh[hh];
                orow[64 * hh] = (bf16_t)(pk2(oA[hh] * il, 0.f) & 0xffffu);
                orow[64 * hh + 32] = (bf16_t)(pk2(oB[hh] * il, 0.f) & 0xffffu);
            }
        }
        asm volatile("s_waitcnt lgkmcnt(0)" ::: "memory");
        __builtin_amdgcn_wave_barrier();
        }
    }
    __syncthreads();
}

constexpr int MB_VT = 0, MB_LIST = 8 * 64 * VTD_LD * 2, MB_WCNT = MB_LIST + 32 * 256 * 2, MB_END = MB_WCNT + 8 * 32 * 4;
static_assert(MB_END <= 131072 && FL_END <= MB_LIST, "MoBA LDS map");
constexpr int PART_LD = 68;
__device__ __forceinline__ void moba_unit(const bf16_t* __restrict__ P, const float* __restrict__ KMEAN, bf16_t* __restrict__ MIX, float* __restrict__ scr,
                                          int b, int h, int qt, char* lds) {
    int tid_ = threadIdx.x; asm volatile("" : "+v"(tid_));
    const int tid = tid_, lane = tid & 63, w = __builtin_amdgcn_readfirstlane(tid >> 6), l32 = lane & 31, hi = lane >> 5;
    constexpr int QOFF = BQ_OFF, KOFF = BK_OFF, VOFF = BV_OFF, OOFF = 256;
    const size_t rowbase = (size_t)b * SEQ;
    const int q0 = qt * 256 + w * 32, myq = q0 + l32, qlocal = w * 32 + l32;
    const bf16_t* qrow = P + (rowbase + myq) * NPROJ + QOFF + 64 * h;
    unsigned short* listb = (unsigned short*)(lds + MB_LIST);
    int* wcnt = (int*)(lds + MB_WCNT);
    bf16_t* Vt = (bf16_t*)(lds + MB_VT) + w * 64 * VTD_LD;
    int i1 = -1, i2 = -1, i3 = -1;
    {
        float v1 = -INFINITY, v2 = -INFINITY, v3 = -INFINITY;
        const float* km = KMEAN + ((size_t)(b * 4 + h) * 32) * 64;
        for (int n = 0; n < qt; ++n) {
            float gsum = 0.f;
#pragma unroll
            for (int c8 = 0; c8 < 8; ++c8) {
                const u32x4 qv = *(const u32x4*)(qrow + 8 * c8);
                const f32x4 k0 = *(const f32x4*)(km + n * 64 + 8 * c8), k1 = *(const f32x4*)(km + n * 64 + 8 * c8 + 4);
                gsum += __uint_as_float(qv.x << 16) * k0[0] + __uint_as_float(qv.x & 0xffff0000u) * k0[1] + __uint_as_float(qv.y << 16) * k0[2] + __uint_as_float(qv.y & 0xffff0000u) * k0[3]
                      + __uint_as_float(qv.z << 16) * k1[0] + __uint_as_float(qv.z & 0xffff0000u) * k1[1] + __uint_as_float(qv.w << 16) * k1[2] + __uint_as_float(qv.w & 0xffff0000u) * k1[3];
            }
            if (gsum > v3) {
                if (gsum > v1) { v3 = v2; i3 = i2; v2 = v1; i2 = i1; v1 = gsum; i1 = n; }
                else if (gsum > v2) { v3 = v2; i3 = i2; v2 = gsum; i2 = n; }
                else { v3 = gsum; i3 = n; }
            }
        }
    }
#ifdef DBG_ZERO_PART
    for (int i = tid; i < 256 * 3 * PART_LD / 4; i += NTHREADS) *(f32x4*)(scr + 4 * i) = (f32x4){0.f, 0.f, 0.f, 0.f};
#endif
    __syncthreads();
    for (int n = 0; n < qt; ++n) {
        const bool pr = (hi == 0) && (i1 == n || i2 == n || i3 == n);
        const unsigned long long mk = __ballot(pr);
        if (lane == 0) wcnt[w * 32 + n] = __builtin_popcountll(mk);
    }
    __syncthreads();
    for (int n = 0; n < qt; ++n) {
        const bool pr = (hi == 0) && (i1 == n || i2 == n || i3 == n);
        const unsigned long long mk = __ballot(pr);
        int base = 0;
        for (int ww = 0; ww < w; ++ww) base += wcnt[ww * 32 + n];
        if (pr) {
            const int slot = (i1 == n) ? 0 : ((i2 == n) ? 1 : 2);
            const int pre = __builtin_amdgcn_mbcnt_hi((unsigned)(mk >> 32), __builtin_amdgcn_mbcnt_lo((unsigned)mk, 0u));
            listb[n * 256 + base + pre] = (unsigned short)(qlocal | (slot << 8));
        }
    }
    __syncthreads();
    {
        const int tq = (lane & 15) >> 2, tp = lane & 3, tc = (lane >> 4) & 1;
        int it = 0;
#pragma unroll 1
        for (int n = 0; n < qt; ++n) {
            int cn = 0;
#pragma unroll
            for (int ww = 0; ww < 8; ++ww) cn += wcnt[ww * 32 + n];
            const int ng = (cn + 31) >> 5;
#pragma unroll 1
            for (int g = 0; g < ng; ++g, ++it) {
                if ((it & 7) != w) continue;
                const int j = 32 * g + l32; const bool valid = j < cn;
                const unsigned ent = listb[n * 256 + (valid ? j : 32 * g)];
                const int ql = (int)(ent & 255u), slot = (int)(ent >> 8);
                const bf16_t* qr = P + (rowbase + qt * 256 + ql) * NPROJ + QOFF + 64 * h;
                bf16x8 qf[4];
#pragma unroll
                for (int ks = 0; ks < 4; ++ks) qf[ks] = *(const bf16x8*)(qr + 16 * ks + 8 * hi);
                float m = -INFINITY, lsum = 0.f;
                f32x16 o0, o1;
#pragma unroll
                for (int r = 0; r < 16; ++r) { o0[r] = 0.f; o1[r] = 0.f; }
                const bf16_t* kb0 = P + (rowbase + 256 * n + l32) * NPROJ + KOFF + 64 * h + 8 * hi;
                const bf16_t* vb0 = P + (rowbase + 256 * n + (lane >> 3)) * NPROJ + VOFF + 64 * h + 8 * (lane & 7);
                bf16x8 ka[2][4]; u32x4 vr[8];
#define MB_LOADK(t_) do { _Pragma("unroll") for (int ks_ = 0; ks_ < 4; ++ks_) { ka[0][ks_] = *(const bf16x8*)(kb0 + (size_t)(64 * (t_)) * NPROJ + 16 * ks_); \
                                                                             ka[1][ks_] = *(const bf16x8*)(kb0 + (size_t)(64 * (t_) + 32) * NPROJ + 16 * ks_); } } while (0)
#define MB_LOADV(t_) do { _Pragma("unroll") for (int i_ = 0; i_ < 8; ++i_) vr[i_] = *(const u32x4*)(vb0 + (size_t)(64 * (t_) + 8 * i_) * NPROJ); } while (0)
                MB_LOADK(0); MB_LOADV(0);
#pragma unroll 1
                for (int t = 0; t < 4; ++t) {
                    f32x16 s0, s1;
#pragma unroll
                    for (int r = 0; r < 16; ++r) { s0[r] = 0.f; s1[r] = 0.f; }
#pragma unroll
                    for (int ks = 0; ks < 4; ++ks) { s0 = mfma32(ka[0][ks], qf[ks], s0); s1 = mfma32(ka[1][ks], qf[ks], s1); }
                    asm volatile("" : "+v"(s0), "+v"(s1));
                    if (t + 1 < 4) MB_LOADK(t + 1);
#pragma unroll
                    for (int i = 0; i < 8; ++i) *(u32x4*)(Vt + (8 * i + (lane >> 3)) * VTD_LD + 8 * (lane & 7)) = vr[i];
                    asm volatile("s_waitcnt lgkmcnt(0)" ::: "memory");
                    __builtin_amdgcn_wave_barrier();
                    float mxa = max3f(s0[0], s0[1], s0[2]), mxb = max3f(s1[0], s1[1], s1[2]);
#pragma unroll
                    for (int r = 3; r < 15; r += 2) { mxa = max3f(mxa, s0[r], s0[r + 1]); mxb = max3f(mxb, s1[r], s1[r + 1]); }
                    float mx = max3f(mxa, mxb, s0[15]); mx = max2f(mx, s1[15]);
                    mx = max2f(mx, __shfl_xor(mx, 32));
                    const float mnew = max2f(m, mx);
                    const float alpha = fexp2(m - mnew);
                    float psum = 0.f;
#pragma unroll
                    for (int r = 0; r < 16; ++r) { s0[r] = fexp2(s0[r] - mnew); s1[r] = fexp2(s1[r] - mnew); psum += s0[r] + s1[r]; }
                    lsum = lsum * alpha + psum; m = mnew;
#pragma unroll
                    for (int r = 0; r < 16; ++r) { o0[r] *= alpha; o1[r] *= alpha; }
                    bf16x8 pk[4];
                    {
                        u32x4 tt;
                        tt.x = pk2(s0[0], s0[1]); tt.y = pk2(s0[2], s0[3]); tt.z = pk2(s0[4], s0[5]); tt.w = pk2(s0[6], s0[7]); pk[0] = __builtin_bit_cast(bf16x8, tt);
                        tt.x = pk2(s0[8], s0[9]); tt.y = pk2(s0[10], s0[11]); tt.z = pk2(s0[12], s0[13]); tt.w = pk2(s0[14], s0[15]); pk[1] = __builtin_bit_cast(bf16x8, tt);
                        tt.x = pk2(s1[0], s1[1]); tt.y = pk2(s1[2], s1[3]); tt.z = pk2(s1[4], s1[5]); tt.w = pk2(s1[6], s1[7]); pk[2] = __builtin_bit_cast(bf16x8, tt);
                        tt.x = pk2(s1[8], s1[9]); tt.y = pk2(s1[10], s1[11]); tt.z = pk2(s1[12], s1[13]); tt.w = pk2(s1[14], s1[15]); pk[3] = __builtin_bit_cast(bf16x8, tt);
                    }
                    asm volatile("" : "+v"(pk[0]), "+v"(pk[1]), "+v"(pk[2]), "+v"(pk[3]));
                    const bf16_t* vtl = Vt + (4 * hi + tq) * VTD_LD + 16 * tc + 4 * tp;
                    asm volatile("" : "+v"(vtl));
#pragma unroll
                    for (int kk = 0; kk < 4; ++kk) {
                        const bf16_t* vrow = vtl + (16 * kk) * VTD_LD;
                        const v4i16_t r1 = ds_tr16(vrow), r2 = ds_tr16(vrow + 8 * VTD_LD);
                        const v4i16_t r3 = ds_tr16(vrow + 32), r4 = ds_tr16(vrow + 8 * VTD_LD + 32);
                        const bf16x8 a0 = (bf16x8){r1[0], r1[1], r1[2], r1[3], r2[0], r2[1], r2[2], r2[3]};
                        const bf16x8 a1 = (bf16x8){r3[0], r3[1], r3[2], r3[3], r4[0], r4[1], r4[2], r4[3]};
                        o0 = mfma32(a0, pk[kk], o0); o1 = mfma32(a1, pk[kk], o1);
                    }
                    asm volatile("" : "+v"(o0), "+v"(o1));
                    asm volatile("s_waitcnt lgkmcnt(0)" ::: "memory");
                    __builtin_amdgcn_wave_barrier();
                    if (t + 1 < 4) MB_LOADV(t + 1);
                }
#undef MB_LOADK
#undef MB_LOADV
                const float ltot = lsum + __shfl_xor(lsum, 32);
                if (valid) {
                    float* pb = scr + (size_t)(ql * 3 + slot) * PART_LD;
#pragma unroll
                    for (int g4 = 0; g4 < 4; ++g4) {
                        f32x4 x0, x1;
                        x0[0] = o0[4 * g4]; x0[1] = o0[4 * g4 + 1]; x0[2] = o0[4 * g4 + 2]; x0[3] = o0[4 * g4 + 3];
                        x1[0] = o1[4 * g4]; x1[1] = o1[4 * g4 + 1]; x1[2] = o1[4 * g4 + 2]; x1[3] = o1[4 * g4 + 3];
                        *(f32x4*)(pb + 8 * g4 + 4 * hi) = x0; *(f32x4*)(pb + 32 + 8 * g4 + 4 * hi) = x1;
                    }
                    if (hi == 0) { pb[64] = m; pb[65] = ltot; }
                }
            }
        }
    }
    __syncthreads();
    __builtin_amdgcn_fence(__ATOMIC_ACQUIRE, "agent");
    bf16x8 qf[4];
#pragma unroll
    for (int ks = 0; ks < 4; ++ks) qf[ks] = *(const bf16x8*)(qrow + 16 * ks + 8 * hi);
    float m = -INFINITY, lsum = 0.f;
    f32x16 o0, o1;
#pragma unroll
    for (int r = 0; r < 16; ++r) { o0[r] = 0.f; o1[r] = 0.f; }
    const int NT = 4 * qt + 4;
    const int kkey = tid >> 3, kch = tid & 7;
    const int vkey = 16 * (w & 3) + (lane & 15), vch = 4 * (w >> 2) + (lane >> 4);
    u32x4 kreg, vreg;
#define MBF_LOAD(kt_) do { kreg = *(const u32x4*)(P + (rowbase + 64 * (kt_) + kkey) * NPROJ + KOFF + 64 * h + 8 * kch); \
        vreg = *(const u32x4*)(P + (rowbase + 64 * (kt_) + vkey) * NPROJ + VOFF + 64 * h + 8 * vch); } while (0)
#define MBF_STORE(buf_) do { bf16_t* Kd_ = (bf16_t*)(lds + (buf_) * FL_BUF + FL_KS); bf16_t* Vd_ = (bf16_t*)(lds + (buf_) * FL_BUF + FL_VT); \
        *(u32x4*)(Kd_ + kkey * KS_LD + 8 * kch) = kreg; \
        bf16_t* vd = Vd_ + (8 * vch) * VT_LD + vkey; \
        vd[0 * VT_LD] = (bf16_t)(vreg.x & 0xffffu); vd[1 * VT_LD] = (bf16_t)(vreg.x >> 16); \
        vd[2 * VT_LD] = (bf16_t)(vreg.y & 0xffffu); vd[3 * VT_LD] = (bf16_t)(vreg.y >> 16); \
        vd[4 * VT_LD] = (bf16_t)(vreg.z & 0xffffu); vd[5 * VT_LD] = (bf16_t)(vreg.z >> 16); \
        vd[6 * VT_LD] = (bf16_t)(vreg.w & 0xffffu); vd[7 * VT_LD] = (bf16_t)(vreg.w >> 16); } while (0)
    int kt = 4 * qt;
    MBF_LOAD(kt);
    MBF_STORE(0);
    __syncthreads();
    int cur = 0;
    while (kt < NT) {
        const int ktc = kt;
        if (kt + 1 < NT) MBF_LOAD(kt + 1);
        ++kt;
        const bf16_t* Ks = (const bf16_t*)(lds + cur * FL_BUF + FL_KS); const bf16_t* VT = (const bf16_t*)(lds + cur * FL_BUF + FL_VT);
        if (!(64 * ktc > q0 + 31)) {
            f32x16 s0, s1;
#pragma unroll
            for (int r = 0; r < 16; ++r) { s0[r] = 0.f; s1[r] = 0.f; }
#pragma unroll
            for (int ks = 0; ks < 4; ++ks) {
                const bf16x8 a0 = *(const bf16x8*)(Ks + l32 * KS_LD + 16 * ks + 8 * hi);
                const bf16x8 a1 = *(const bf16x8*)(Ks + (32 + l32) * KS_LD + 16 * ks + 8 * hi);
                s0 = mfma32(a0, qf[ks], s0); s1 = mfma32(a1, qf[ks], s1);
            }
            if (64 * ktc + 63 > q0) {
#pragma unroll
                for (int r = 0; r < 16; ++r) {
                    const int kg = 64 * ktc + 8 * (r >> 2) + 4 * hi + (r & 3);
                    if (kg > myq) s0[r] = -INFINITY;
                    if (kg + 32 > myq) s1[r] = -INFINITY;
                }
            }
            float mxa = max3f(s0[0], s0[1], s0[2]), mxb = max3f(s1[0], s1[1], s1[2]);
#pragma unroll
            for (int r = 3; r < 15; r += 2) { mxa = max3f(mxa, s0[r], s0[r + 1]); mxb = max3f(mxb, s1[r], s1[r + 1]); }
            float mx = max3f(mxa, mxb, s0[15]); mx = max2f(mx, s1[15]);
            mx = max2f(mx, __shfl_xor(mx, 32));
            const float mnew = max2f(m, mx);
            const float msafe = (mnew == -INFINITY) ? 0.f : mnew;
            const float alpha = fexp2(m - msafe);
            float psum = 0.f;
#pragma unroll
            for (int r = 0; r < 16; ++r) { s0[r] = fexp2(s0[r] - msafe); s1[r] = fexp2(s1[r] - msafe); psum += s0[r] + s1[r]; }
            lsum = lsum * alpha + psum; m = mnew;
#pragma unroll
            for (int r = 0; r < 16; ++r) { o0[r] *= alpha; o1[r] *= alpha; }
            bf16x8 pk[4];
            {
                u32x4 tt;
                tt.x = pk2(s0[0], s0[1]); tt.y = pk2(s0[2], s0[3]); tt.z = pk2(s0[4], s0[5]); tt.w = pk2(s0[6], s0[7]); pk[0] = __builtin_bit_cast(bf16x8, tt);
                tt.x = pk2(s0[8], s0[9]); tt.y = pk2(s0[10], s0[11]); tt.z = pk2(s0[12], s0[13]); tt.w = pk2(s0[14], s0[15]); pk[1] = __builtin_bit_cast(bf16x8, tt);
                tt.x = pk2(s1[0], s1[1]); tt.y = pk2(s1[2], s1[3]); tt.z = pk2(s1[4], s1[5]); tt.w = pk2(s1[6], s1[7]); pk[2] = __builtin_bit_cast(bf16x8, tt);
                tt.x = pk2(s1[8], s1[9]); tt.y = pk2(s1[10], s1[11]); tt.z = pk2(s1[12], s1[13]); tt.w = pk2(s1[14], s1[15]); pk[3] = __builtin_bit_cast(bf16x8, tt);
            }
#pragma unroll
            for (int kk = 0; kk < 4; ++kk) {
                u32x4 a, c;
                const u32x2 a_lo = *(const u32x2*)(VT + l32 * VT_LD + 16 * kk + 4 * hi), a_hi = *(const u32x2*)(VT + l32 * VT_LD + 16 * kk + 8 + 4 * hi);
                const u32x2 c_lo = *(const u32x2*)(VT + (32 + l32) * VT_LD + 16 * kk + 4 * hi), c_hi = *(const u32x2*)(VT + (32 + l32) * VT_LD + 16 * kk + 8 + 4 * hi);
                a.x = a_lo.x; a.y = a_lo.y; a.z = a_hi.x; a.w = a_hi.y; c.x = c_lo.x; c.y = c_lo.y; c.z = c_hi.x; c.w = c_hi.y;
                o0 = mfma32(__builtin_bit_cast(bf16x8, a), pk[kk], o0);
                o1 = mfma32(__builtin_bit_cast(bf16x8, c), pk[kk], o1);
            }
        }
        if (kt < NT) MBF_STORE(cur ^ 1);
        __syncthreads();
        cur ^= 1;
    }
#undef MBF_LOAD
#undef MBF_STORE
    float ltot = lsum + __shfl_xor(lsum, 32);
#pragma unroll
    for (int sl = 0; sl < 3; ++sl) {
        const int bi = (sl == 0) ? i1 : ((sl == 1) ? i2 : i3);
#ifdef DBG_NOMERGE
        if (bi >= 1000 + (int)blockIdx.x) {
#else
        if (bi >= 0) {
#endif
            float* pb = scr + (size_t)(qlocal * 3 + sl) * PART_LD;
            const float mp = pb[64], lp = pb[65];
            const float mn = max2f(m, mp);
            const float fa = fexp2(m - mn), fb = fexp2(mp - mn);
            ltot = ltot * fa + lp * fb; m = mn;
#pragma unroll
            for (int g4 = 0; g4 < 4; ++g4) {
                const f32x4 x0 = *(const f32x4*)(pb + 8 * g4 + 4 * hi), x1 = *(const f32x4*)(pb + 32 + 8 * g4 + 4 * hi);
#pragma unroll
                for (int i = 0; i < 4; ++i) { o0[4 * g4 + i] = o0[4 * g4 + i] * fa + x0[i] * fb; o1[4 * g4 + i] = o1[4 * g4 + i] * fa + x1[i] * fb; }
            }
        }
    }
    const float inv = 1.0f / ltot;
    bf16_t* orow = MIX + (rowbase + myq) * DM + OOFF + 64 * h;
#pragma unroll
    for (int g4 = 0; g4 < 4; ++g4) {
        const int d = 8 * g4 + 4 * hi;
        u32x2 wa, wc2;
        wa.x = pk2(o0[4 * g4] * inv, o0[4 * g4 + 1] * inv); wa.y = pk2(o0[4 * g4 + 2] * inv, o0[4 * g4 + 3] * inv);
        wc2.x = pk2(o1[4 * g4] * inv, o1[4 * g4 + 1] * inv); wc2.y = pk2(o1[4 * g4 + 2] * inv, o1[4 * g4 + 3] * inv);
        *(u32x2*)(orow + d) = wa; *(u32x2*)(orow + 32 + d) = wc2;
    }
    __syncthreads();
}

constexpr int UNITS_PER_LEVEL = 8 + 4 + 8, N_ATT_UNITS = 32 * UNITS_PER_LEVEL;
__device__ __forceinline__ void attn_phase(const bf16_t* P, const float* IW, const float* CUM, const float* KMEAN, bf16_t* MIX, float* scr, unsigned* counters, const float* gq, const float* gk, char* lds) {
    int* s_unit = (int*)(lds + MISC_OFF);
    for (int qi = 0; qi < NB; ++qi) {
        const int b = (int)((blockIdx.x + qi) & (NB - 1));
        unsigned* counter = counters + 64 * b;
        for (;;) {
            __syncthreads();
            if (threadIdx.x == 0) *s_unit = (int)atomicAdd(counter, 1u);
            __syncthreads();
            const int u = *s_unit;
            if (u >= N_ATT_UNITS) break;
            const int lvl = 31 - u / UNITS_PER_LEVEL, j = u % UNITS_PER_LEVEL;
            int reps_f = 1, reps_d = 1;
#ifdef PROBE_FLASH2
            reps_f = 2;
#endif
#ifdef PROBE_DSA2
            reps_d = 2;
#endif
#pragma unroll 1
            for (int rep_ = 0; rep_ < (j < 12 ? reps_f : reps_d); ++rep_) {
                if (j < 8) flash_unit<0>(P, CUM, KMEAN, MIX, gq, gk, b, j, lvl, lds);
#ifdef MOBA_DENSE
                else if (j < 12) flash_unit<1>(P, CUM, KMEAN, MIX, gq, gk, b, j - 8, lvl, lds);
#else
                else if (j < 12) moba_unit(P, KMEAN, MIX, scr, b, j - 8, lvl, lds);
#endif
                else dsa_unit(P, IW, MIX, scr, b, 8 * lvl + (j - 12), lds);
            }
        }
    }
}

constexpr int N_PHASES = 1 + 8 * DEPTH;
#define PH_IN(p) (lo <= (p) && (p) < hi)
#define PH_SYNC(p) do { if (PH_IN(p) && PH_IN((p) + 1)) cg::this_grid().sync(); } while (0)
__device__ __forceinline__ void prologue_phase(const Args& args, char* lds) {
    unsigned char* ws = args.ws;
    const int tid = threadIdx.x, lane = tid & 63, wave = tid >> 6;
    float* scr = (float*)(lds + wave * 16384);
    const int gw = blockIdx.x * 8 + wave, ngw = gridDim.x * 8;
    for (int mat = 0; mat < 16; ++mat) {
        const int l = mat >> 3, k = mat & 7;
        const float* src; const float* gain = nullptr; int K, N, kind; size_t dst;
        if (k == 0) { src = args.in[2] + (size_t)l * DM * DFF; gain = args.in[1] + l * DM; K = DM; N = DFF; kind = 1; dst = WL_GU1; }
        else if (k == 1) { src = args.in[3] + (size_t)l * DM * DFF; gain = args.in[1] + l * DM; K = DM; N = DFF; kind = 2; dst = WL_GU1; }
        else if (k == 2) { src = args.in[4] + (size_t)l * DFF * DM; K = DFF; N = DM; kind = 0; dst = WL_D1; }
        else if (k == 3) { src = args.in[16] + (size_t)l * DM * DFF; gain = args.in[15] + l * DM; K = DM; N = DFF; kind = 1; dst = WL_GU2; }
        else if (k == 4) { src = args.in[17] + (size_t)l * DM * DFF; gain = args.in[15] + l * DM; K = DM; N = DFF; kind = 2; dst = WL_GU2; }
        else if (k == 5) { src = args.in[18] + (size_t)l * DFF * DM; K = DFF; N = DM; kind = 0; dst = WL_D2; }
        else if (k == 6) { src = args.in[6] + (size_t)l * DM * INW; gain = args.in[5] + l * DM; K = DM; N = INW; kind = 3; dst = WL_IN; }
        else { src = args.in[14] + (size_t)l * DM * DM; K = DM; N = DM; kind = 0; dst = WL_OUT; }
        bf16_t* WT = (bf16_t*)(ws + WS_W + (size_t)l * WL_BYTES + dst);
        const int nitems = (K / 64) * ((N + 31) / 32);
        for (int it = gw; it < nitems; it += ngw) transpose_item(src, gain, K, N, WT, kind, scr, it, lane);
    }
    for (int i = blockIdx.x * NTHREADS + tid; i < DEPTH * 48 * 128; i += gridDim.x * NTHREADS) {
        const int l = i / (48 * 128), r = (i / 128) % 48, c = i % 128, d = 16 + r;
        bf16_t* WT = (bf16_t*)(ws + WS_W + (size_t)l * WL_BYTES + WL_IN);
        *(u32x4*)(WT + (size_t)(256 * 14 + 128 * (d >> 5) + 96 + (d & 31)) * DM + 8 * c) = (u32x4){0u, 0u, 0u, 0u};
    }
    float* COS = (float*)(ws + WS_COS); float* SIN = (float*)(ws + WS_SIN);
    for (int i = blockIdx.x * NTHREADS + tid; i < SEQ * 32; i += gridDim.x * NTHREADS) {
        const int pos = i >> 5, f = i & 31;
        const float inv = 1.0f / powf(10000.0f, (float)(2 * f) / 64.0f);
        const float ang = (float)pos * inv;
        COS[i] = (float)cos((double)ang); SIN[i] = (float)sin((double)ang);
    }
    float* SS = (float*)(ws + WS_SS);
    for (int m0 = 4 * gw; m0 < MTOK; m0 += 4 * ngw) {
        f32x4 v[4][4];
#pragma unroll
        for (int r = 0; r < 4; ++r)
#pragma unroll
            for (int j = 0; j < 4; ++j) v[r][j] = *((const f32x4*)(args.in[0] + (size_t)(m0 + r) * DM) + lane + 64 * j);
#pragma unroll
        for (int r = 0; r < 4; ++r) {
            float sq = 0.f;
#pragma unroll
            for (int j = 0; j < 4; ++j) sq += (v[r][j][0] * v[r][j][0] + v[r][j][1] * v[r][j][1]) + (v[r][j][2] * v[r][j][2] + v[r][j][3] * v[r][j][3]);
            sq = wave_sum(sq);
            u32x2* o8 = (u32x2*)((bf16_t*)(ws + WS_XN) + (size_t)(m0 + r) * DM) + lane;
#pragma unroll
            for (int j = 0; j < 4; ++j) { u32x2 wv; wv.x = pk2(v[r][j][0], v[r][j][1]); wv.y = pk2(v[r][j][2], v[r][j][3]); o8[64 * j] = wv; }
            if (lane < 16) SS[(size_t)(m0 + r) * 16 + lane] = (lane == 0) ? sq : 0.f;
        }
    }
}
template <int L>
__device__ __forceinline__ void layer_phases(const Args& args, unsigned char* lds_raw, const int lo, const int hi) {
    char* lds = (char*)lds_raw;
    unsigned char* ws = args.ws;
    constexpr int P0 = 1 + 8 * L;
    float* SSb = (float*)(ws + WS_SS);
    if (PH_IN(P0 + 0)) {
        pg8::Gemm g{(const bf16_t*)(ws + WS_XN), (const bf16_t*)(ws + WS_W + (size_t)L * WL_BYTES + WL_GU1), MTOK, 2 * DFF, DM};
        pg8::StaticOrder S; S.init(MTOK, 2 * DFF, (int)gridDim.x, (int)blockIdx.x);
        EpiSwiglu E{(bf16_t*)(ws + WS_BIG), SSb + (size_t)(3 * L + 0) * MTOK * 16};
        pg8::gemm_phase<EpiSwiglu, pg8::StaticOrder, true, true>((PG8_LAS unsigned char*)lds_raw, g, S, E);
#ifdef PROBE_GU2
        __syncthreads();
        pg8::gemm_phase<EpiSwiglu, pg8::StaticOrder, true, true>((PG8_LAS unsigned char*)lds_raw, g, S, E);
#endif
    }
    PH_SYNC(P0 + 0);
    if (PH_IN(P0 + 1)) {
        pg8::Gemm g{(const bf16_t*)(ws + WS_BIG), (const bf16_t*)(ws + WS_W + (size_t)L * WL_BYTES + WL_D1), MTOK, DM, DFF};
        pg8::StaticOrder S; S.init(MTOK, DM, (int)gridDim.x, (int)blockIdx.x);
        EpiResid<true, 1> E{L == 0 ? args.in[0] : args.out, args.out, (bf16_t*)(ws + WS_XN), SSb + (size_t)(3 * L + 1) * MTOK * 16};
        pg8::gemm_phase<EpiResid<true, 1>, pg8::StaticOrder, false, true>((PG8_LAS unsigned char*)lds_raw, g, S, E);
    }
    PH_SYNC(P0 + 1);
    if (PH_IN(P0 + 2)) {
        pg8::Gemm g{(const bf16_t*)(ws + WS_XN), (const bf16_t*)(ws + WS_W + (size_t)L * WL_BYTES + WL_IN), MTOK, NPROJ, DM};
        pg8::StaticOrder S; S.init(MTOK, NPROJ, (int)gridDim.x, (int)blockIdx.x);
        EpiProj E{(bf16_t*)(ws + WS_BIG), (float*)(ws + WS_IW), (float*)(ws + WS_LF), (const float*)(ws + WS_COS), (const float*)(ws + WS_SIN),
                  args.in[8] + L * 64, args.in[9] + L * 64, args.in[10] + L * 64, args.in[11] + L * 64, args.in[12] + L * 64, args.in[13] + L * 64, args.in[7] + L * 8,
                  SSb + (size_t)(3 * L + 1) * MTOK * 16};
        pg8::gemm_phase<EpiProj, pg8::StaticOrder, true, true>((PG8_LAS unsigned char*)lds_raw, g, S, E);
#ifdef PROBE_IN2
        __syncthreads();
        pg8::gemm_phase<EpiProj, pg8::StaticOrder, true, true>((PG8_LAS unsigned char*)lds_raw, g, S, E);
#endif
    }
    PH_SYNC(P0 + 2);
    if (PH_IN(P0 + 3)) scan_kmean_phase((const float*)(ws + WS_LF), (float*)(ws + WS_CUM), (const bf16_t*)(ws + WS_BIG), (float*)(ws + WS_KMEAN), lds);
#ifdef PROBE_SCAN2
    if (PH_IN(P0 + 3)) { __syncthreads(); scan_kmean_phase((const float*)(ws + WS_LF), (float*)(ws + WS_CUM), (const bf16_t*)(ws + WS_BIG), (float*)(ws + WS_KMEAN), lds); }
#endif
    PH_SYNC(P0 + 3);
    if (PH_IN(P0 + 4))
        attn_phase((const bf16_t*)(ws + WS_BIG), (const float*)(ws + WS_IW), (const float*)(ws + WS_CUM), (const float*)(ws + WS_KMEAN), (bf16_t*)(ws + WS_XN),
                   (float*)(ws + WS_SCR) + (size_t)blockIdx.x * 32 * SEQ, (unsigned*)(ws + WS_CTL) + 64 * 8 * L, args.in[12] + L * 64, args.in[13] + L * 64, lds);
    PH_SYNC(P0 + 4);
    if (PH_IN(P0 + 5)) {
        pg8::Gemm g{(const bf16_t*)(ws + WS_XN), (const bf16_t*)(ws + WS_W + (size_t)L * WL_BYTES + WL_OUT), MTOK, DM, DM};
        pg8::StaticOrder S; S.init(MTOK, DM, (int)gridDim.x, (int)blockIdx.x);
        EpiResid<true, 2> E{args.out, args.out, (bf16_t*)(ws + WS_HBB), SSb + (size_t)(3 * L + 2) * MTOK * 16};
        pg8::gemm_phase<EpiResid<true, 2>, pg8::StaticOrder, false, true>((PG8_LAS unsigned char*)lds_raw, g, S, E);
    }
    PH_SYNC(P0 + 5);
    if (PH_IN(P0 + 6)) {
        pg8::Gemm g{(const bf16_t*)(ws + WS_HBB), (const bf16_t*)(ws + WS_W + (size_t)L * WL_BYTES + WL_GU2), MTOK, 2 * DFF, DM};
        pg8::StaticOrder S; S.init(MTOK, 2 * DFF, (int)gridDim.x, (int)blockIdx.x);
        EpiSwiglu E{(bf16_t*)(ws + WS_BIG), SSb + (size_t)(3 * L + 2) * MTOK * 16};
        pg8::gemm_phase<EpiSwiglu, pg8::StaticOrder, true, true>((PG8_LAS unsigned char*)lds_raw, g, S, E);
    }
    PH_SYNC(P0 + 6);
    if (PH_IN(P0 + 7)) {
        pg8::Gemm g{(const bf16_t*)(ws + WS_BIG), (const bf16_t*)(ws + WS_W + (size_t)L * WL_BYTES + WL_D2), MTOK, DM, DFF};
        pg8::StaticOrder S; S.init(MTOK, DM, (int)gridDim.x, (int)blockIdx.x);
        EpiResid<(L + 1 < DEPTH), 1> E{args.out, args.out, (bf16_t*)(ws + WS_XN), SSb + (size_t)(3 * (L + 1 < DEPTH ? L + 1 : 0)) * MTOK * 16};
        pg8::gemm_phase<EpiResid<(L + 1 < DEPTH), 1>, pg8::StaticOrder, false, true>((PG8_LAS unsigned char*)lds_raw, g, S, E);
    }
    PH_SYNC(P0 + 7);
}
__global__ void __launch_bounds__(NTHREADS, 2) fwd_kernel(Args args) {
    extern __shared__ __attribute__((aligned(16))) unsigned char lds_raw[];
    const int lo = args.ph_lo, hi = args.ph_hi;
    if (PH_IN(0)) prologue_phase(args, (char*)lds_raw);
#ifdef PROBE_PRO2
    if (PH_IN(0)) { __syncthreads(); prologue_phase(args, (char*)lds_raw); }
#endif
    PH_SYNC(0);
    layer_phases<0>(args, lds_raw, lo, hi);
    layer_phases<1>(args, lds_raw, lo, hi);
}

extern "C" void kernel_launch(void* const* d_in, const int* in_sizes, int n_in, void* d_out, int out_size, void* d_ws, size_t ws_size, hipStream_t stream) {
    static int grid = 0;
    if (grid == 0) {
        if (n_in != 19 || out_size != MTOK * DM || ws_size < WS_END) { fprintf(stderr, "kernel_launch: unexpected shapes (n_in %d out %d ws %zu)\n", n_in, out_size, ws_size); grid = -1; return; }
        int dev = 0, cus = 0, per_cu = 0;
        hipGetDevice(&dev); hipDeviceGetAttribute(&cus, hipDeviceAttributeMultiprocessorCount, dev);
        hipFuncSetAttribute((const void*)fwd_kernel, hipFuncAttributeMaxDynamicSharedMemorySize, LDS_BYTES);
        hipOccupancyMaxActiveBlocksPerMultiprocessor(&per_cu, (const void*)fwd_kernel, NTHREADS, LDS_BYTES);
        (void)hipGetLastError();
        grid = cus * (per_cu < 1 ? 1 : 1);
        if (grid > 256) grid = 256;
        if (grid < 1) grid = 256;
    }
    if (grid < 0) return;
    hipMemsetAsync((char*)d_ws + WS_CTL, 0, 4096, stream);
    Args a{};
    for (int i = 0; i < 19; ++i) a.in[i] = (const float*)d_in[i];
    a.out = (float*)d_out; a.ws = (unsigned char*)d_ws;
#if MK_ONE_LAUNCH
    a.ph_lo = 0; a.ph_hi = N_PHASES;
    void* kargs[] = {&a};
    hipError_t e = hipLaunchCooperativeKernel((const void*)fwd_kernel, dim3(grid), dim3(NTHREADS), kargs, LDS_BYTES, stream);
    if (e != hipSuccess) fprintf(stderr, "cooperative launch failed: %s (grid %d)\n", hipGetErrorString(e), grid);
#else
    for (int ph = 0; ph < N_PHASES; ++ph) {
        a.ph_lo = ph; a.ph_hi = ph + 1;
        hipLaunchKernelGGL(fwd_kernel, dim3(grid), dim3(NTHREADS), LDS_BYTES, stream, a);
    }
#endif
}
```

```cpp
#include <hip/hip_runtime.h>
#include <hip/hip_cooperative_groups.h>
#include <cstdio>
#include <cstdint>
namespace cg = cooperative_groups;
namespace pg8 {
#define PG8_LAS __attribute__((address_space(3)))
typedef unsigned short bf16_t;
typedef short bf16x8 __attribute__((ext_vector_type(8)));
typedef float f32x4 __attribute__((ext_vector_type(4)));
typedef unsigned u32x4 __attribute__((ext_vector_type(4)));
constexpr int BM = 256, BK = 64, HALF = 128, HTB = HALF * BK * 2  , STAGE_BYTES = 8 * HTB, NXCD = 8, WGM = 8;

__host__ __device__ __forceinline__ int lds_byte(int r, int c) { const int st = (r >> 4) * 2 + (c >> 5), rr = r & 15, cc = c & 31, ob = rr * 64 + cc * 2; return st * 1024 + (ob ^ (((ob >> 9) & 1) << 5)); }
__host__ __device__ __forceinline__ void stage_rc(int b, int& R, int& C) { const int st = b / 1024, sb = b % 1024, swz = sb ^ (((sb >> 9) & 1) << 5); R = (st >> 1) * 16 + swz / 64; C = (st & 1) * 32 + (swz % 64) / 2; }
__host__ __device__ __forceinline__ int perm32(int rho) { const int n = rho >> 4, i = rho & 15; return 8 * (i >> 2) + 4 * n + (i & 3); }

struct Unit { int pm, pn; };
struct Gemm { const bf16_t* A; const bf16_t* Bt; int M, N, K; };

struct StaticOrder {
    int nM, nN, nwg, G, c;
    __host__ __device__ void init(int M, int N, int G_, int c_) { nM = M / BM; nN = N / BM; nwg = nM * nN; G = G_; c = c_; }
    __host__ __device__ bool next(int i, Unit& u) const {
        const long L = (long)i * G + c; if (L >= nwg) return false;
        int wgid = (int)L; { const int q = nwg / NXCD, r = nwg % NXCD, xcd = wgid % NXCD, off = wgid / NXCD; wgid = (xcd < r ? xcd * (q + 1) : r * (q + 1) + (xcd - r) * q) + off; }
        const int nig = WGM * nN, gid = wgid / nig, fm = gid * WGM, gsz = (nM - fm) < WGM ? (nM - fm) : WGM;
        u.pm = fm + ((wgid % nig) % gsz); u.pn = (wgid % nig) / gsz; return true;
    }
    __device__ __forceinline__ void a_ready(const Unit&) const {}
    __device__ __forceinline__ void done(const Unit&) const {}
};

__device__ __forceinline__ unsigned cvt_pk_bf16(float lo, float hi) { unsigned r; asm volatile("v_cvt_pk_bf16_f32 %0, %1, %2" : "=v"(r) : "v"(lo), "v"(hi)); return r; }
template <class Epi, class Sched, bool ALIGN_EPI = false, bool SP2 = false>
__device__ __forceinline__ void gemm_phase(PG8_LAS unsigned char* lds, const Gemm g, const Sched& S, const Epi& E) {
    const int tid = threadIdx.x, wid = __builtin_amdgcn_readfirstlane(tid >> 6), lane = tid & 63, wr = wid >> 2, wc = wid & 3, fr = lane & 15, fq = lane >> 4;
    const int K = g.K, nt = K / BK;
    unsigned voffA[2], voffB[2];
#pragma unroll
    for (int i = 0; i < 2; ++i) { int R, C; stage_rc(tid * 16 + i * 8192, R, C); const int Rb = Epi::PERM ? ((R & ~31) + perm32(R & 31)) : R;
        voffA[i] = (unsigned)(R * K + C) * 2u; voffB[i] = (unsigned)(Rb * K + C) * 2u; }
    const size_t kstep = (size_t)(BK * 2);
    const size_t hstep = (size_t)HALF * K * 2;
    const size_t tstep = 2 * hstep;
    const unsigned ldsw = (unsigned)wid * 1024u;
    const int aoff = lds_byte(wr * 64 + fr, fq * 8), boff = lds_byte(wc * 32 + fr, fq * 8);
#define PG8_SA(b, h) (((b) * 2 + (h)) * HTB)
#define PG8_SB(b, h) ((4 + (b) * 2 + (h)) * HTB)
#define PG8_STAGE(bufoff, gbase, voff) do { _Pragma("unroll") for (int _i = 0; _i < 2; ++_i) \
        __builtin_amdgcn_global_load_lds((const unsigned*)((const char*)(gbase) + (voff)[_i]), (PG8_LAS unsigned*)(lds + (bufoff) + ldsw + _i * 8192), 16, 0, 0); } while (0)
#define PG8_LDA(dst, b, h) do { _Pragma("unroll") for (int m = 0; m < 4; ++m) _Pragma("unroll") for (int k = 0; k < 2; ++k) dst[m][k] = *(const PG8_LAS bf16x8*)(lds + PG8_SA(b, h) + aoff + m * 2048 + k * 1024); } while (0)
#define PG8_LDB(dst, b, h) do { _Pragma("unroll") for (int n = 0; n < 2; ++n) _Pragma("unroll") for (int k = 0; k < 2; ++k) dst[n][k] = *(const PG8_LAS bf16x8*)(lds + PG8_SB(b, h) + boff + n * 2048 + k * 1024); } while (0)
#define PG8_MMA(ai, bj, At, Bt) do { __builtin_amdgcn_s_setprio(1); _Pragma("unroll") for (int m = 0; m < 4; ++m) _Pragma("unroll") for (int n = 0; n < 2; ++n) _Pragma("unroll") for (int k = 0; k < 2; ++k) \
        acc[ai][bj][m][n] = __builtin_amdgcn_mfma_f32_16x16x32_bf16(Bt[n][k], At[m][k], acc[ai][bj][m][n], 0, 0, 0); __builtin_amdgcn_s_setprio(0); } while (0)
#define PG8_WAIT_V(n) asm volatile("s_waitcnt vmcnt(" #n ")" ::: "memory")
#define PG8_WAIT_L(n) asm volatile("s_waitcnt lgkmcnt(" #n ")" ::: "memory")
#define PG8_BAR __builtin_amdgcn_s_barrier()
#define PG8_SCHED __builtin_amdgcn_sched_barrier(0)
    Unit cur, nxt; int ui = 0;
    if (!S.next(0, cur)) return;
    f32x4 acc[2][2][4][2];
#pragma unroll
    for (int a = 0; a < 2; ++a)
#pragma unroll
        for (int b = 0; b < 2; ++b)
#pragma unroll
            for (int m = 0; m < 4; ++m)
#pragma unroll
                for (int n = 0; n < 2; ++n) acc[a][b][m][n] = (f32x4){0.f, 0.f, 0.f, 0.f};
    bf16x8 At[4][2], B0[2][2], B1[2][2];
    const char* cA = (const char*)g.A + (size_t)cur.pm * tstep; const char* cB = (const char*)g.Bt + (size_t)cur.pn * tstep;
    S.a_ready(cur);
    if constexpr (SP2) {
        PG8_STAGE(PG8_SB(0, 0), cB, voffB); PG8_STAGE(PG8_SB(0, 1), cB + hstep, voffB); PG8_STAGE(PG8_SA(0, 0), cA, voffA); PG8_STAGE(PG8_SA(0, 1), cA + hstep, voffA);
        if (wr == 1) PG8_BAR;
        PG8_WAIT_V(2); PG8_BAR;
        PG8_STAGE(PG8_SB(1, 0), cB + kstep, voffB); PG8_STAGE(PG8_SA(1, 0), cA + kstep, voffA); PG8_STAGE(PG8_SB(1, 1), cB + hstep + kstep, voffB);
        PG8_WAIT_V(6); PG8_BAR;
    } else {
        PG8_STAGE(PG8_SB(0, 0), cB, voffB); PG8_STAGE(PG8_SA(0, 0), cA, voffA); PG8_STAGE(PG8_SB(0, 1), cB + hstep, voffB); PG8_STAGE(PG8_SA(0, 1), cA + hstep, voffA);
        if (wr == 1) PG8_BAR;
        PG8_WAIT_V(4); PG8_BAR;
        PG8_STAGE(PG8_SB(1, 0), cB + kstep, voffB); PG8_STAGE(PG8_SA(1, 0), cA + kstep, voffA); PG8_STAGE(PG8_SB(1, 1), cB + hstep + kstep, voffB);
        PG8_WAIT_V(6); PG8_BAR;
    }
    for (;;) {
        const bool has_next = S.next(ui + 1, nxt);
        const char* nA = has_next ? (const char*)g.A + (size_t)nxt.pm * tstep : cA; const char* nB = has_next ? (const char*)g.Bt + (size_t)nxt.pn * tstep : cB;
        for (int t = 0; t < nt; t += 2) {
            const bool last = (t == nt - 2);
            const char* a1 = cA + (size_t)(t + 1) * kstep;
            const char* a2 = last ? nA : cA + (size_t)(t + 2) * kstep; const char* b2 = last ? nB : cB + (size_t)(t + 2) * kstep;
            const char* a3 = a2 + kstep; const char* b3 = b2 + kstep;
            if (last && has_next) S.a_ready(nxt);
            if constexpr (SP2) {
            PG8_LDB(B0, 0, 0); PG8_LDB(B1, 0, 1); PG8_SCHED; PG8_LDA(At, 0, 0); PG8_STAGE(PG8_SA(1, 1), a1 + hstep, voffA);
            PG8_WAIT_V(8); PG8_WAIT_L(0); PG8_BAR; PG8_MMA(0, 0, At, B0); PG8_MMA(0, 1, At, B1); PG8_BAR; PG8_SCHED;
            PG8_LDA(At, 0, 1); PG8_STAGE(PG8_SB(0, 0), b2, voffB); PG8_STAGE(PG8_SB(0, 1), b2 + hstep, voffB); PG8_STAGE(PG8_SA(0, 0), a2, voffA);
            PG8_WAIT_V(8); PG8_WAIT_L(0); PG8_BAR; PG8_MMA(1, 0, At, B0); PG8_MMA(1, 1, At, B1); PG8_BAR; PG8_SCHED;
            PG8_LDB(B0, 1, 0); PG8_LDB(B1, 1, 1); PG8_SCHED; PG8_LDA(At, 1, 0); PG8_STAGE(PG8_SA(0, 1), a2 + hstep, voffA);
            PG8_WAIT_V(8); PG8_WAIT_L(0); PG8_BAR; PG8_MMA(0, 0, At, B0); PG8_MMA(0, 1, At, B1); PG8_BAR; PG8_SCHED;
            PG8_LDA(At, 1, 1); PG8_STAGE(PG8_SB(1, 0), b3, voffB); PG8_STAGE(PG8_SB(1, 1), b3 + hstep, voffB); PG8_STAGE(PG8_SA(1, 0), a3, voffA);
            PG8_WAIT_V(8); PG8_WAIT_L(0); PG8_BAR; PG8_MMA(1, 0, At, B0); PG8_MMA(1, 1, At, B1); PG8_BAR; PG8_SCHED;
            } else {
            PG8_LDB(B0, 0, 0); PG8_SCHED; PG8_LDA(At, 0, 0); PG8_STAGE(PG8_SA(1, 1), a1 + hstep, voffA);
            PG8_WAIT_L(8); PG8_BAR; PG8_WAIT_L(0); PG8_MMA(0, 0, At, B0); PG8_BAR; PG8_SCHED;
            PG8_LDB(B1, 0, 1); PG8_STAGE(PG8_SB(0, 0), b2, voffB);
            PG8_BAR; PG8_WAIT_L(0); PG8_MMA(0, 1, At, B1); PG8_BAR;
            PG8_LDA(At, 0, 1); PG8_STAGE(PG8_SA(0, 0), a2, voffA);
            PG8_BAR; PG8_WAIT_L(0); PG8_MMA(1, 0, At, B0); PG8_BAR; PG8_SCHED;
            PG8_STAGE(PG8_SB(0, 1), b2 + hstep, voffB);
            PG8_WAIT_V(6); PG8_BAR; PG8_MMA(1, 1, At, B1); PG8_BAR;
            PG8_LDB(B0, 1, 0); PG8_SCHED; PG8_LDA(At, 1, 0); PG8_STAGE(PG8_SA(0, 1), a2 + hstep, voffA);
            PG8_WAIT_L(8); PG8_BAR; PG8_WAIT_L(0); PG8_MMA(0, 0, At, B0); PG8_BAR; PG8_SCHED;
            PG8_LDB(B1, 1, 1); PG8_STAGE(PG8_SB(1, 0), b3, voffB);
            PG8_BAR; PG8_WAIT_L(0); PG8_MMA(0, 1, At, B1); PG8_BAR;
            PG8_LDA(At, 1, 1); PG8_STAGE(PG8_SA(1, 0), a3, voffA);
            PG8_BAR; PG8_WAIT_L(0); PG8_MMA(1, 0, At, B0); PG8_BAR; PG8_SCHED;
            PG8_STAGE(PG8_SB(1, 1), b3 + hstep, voffB);
            PG8_WAIT_V(6); PG8_BAR; PG8_MMA(1, 1, At, B1); PG8_BAR;
            }
        }
        if constexpr (ALIGN_EPI) { if (wr == 0) PG8_BAR; }
        if constexpr (!Epi::AFTER_DRAIN) { E(acc, cur, wr, wc, fr, fq); S.done(cur); }
        if (!has_next) break;
#pragma unroll
        for (int a = 0; a < 2; ++a)
#pragma unroll
            for (int b = 0; b < 2; ++b)
#pragma unroll
                for (int m = 0; m < 4; ++m)
#pragma unroll
                    for (int n = 0; n < 2; ++n) acc[a][b][m][n] = (f32x4){0.f, 0.f, 0.f, 0.f};
        cur = nxt; cA = nA; cB = nB; ++ui;
        if constexpr (ALIGN_EPI) { if (wr == 1) PG8_BAR; }
    }
    PG8_WAIT_V(0);
    if constexpr (!ALIGN_EPI) { if (wr == 0) PG8_BAR; }
    PG8_BAR;
    if constexpr (Epi::AFTER_DRAIN) { E.fused(acc, cur, wr, wc, fr, fq, lds, wid, lane); S.done(cur); }
#undef PG8_SA
#undef PG8_SB
#undef PG8_STAGE
#undef PG8_LDA
#undef PG8_LDB
#undef PG8_MMA
#undef PG8_WAIT_V
#undef PG8_WAIT_L
#undef PG8_BAR
#undef PG8_SCHED
}
}

#ifndef MK_ONE_LAUNCH
#define MK_ONE_LAUNCH 1
#endif
typedef unsigned short bf16_t;
typedef short bf16x8 __attribute__((ext_vector_type(8)));
typedef float f32x4 __attribute__((ext_vector_type(4)));
typedef float f32x16 __attribute__((ext_vector_type(16)));
typedef unsigned u32x4 __attribute__((ext_vector_type(4)));
typedef unsigned u32x2 __attribute__((ext_vector_type(2)));

constexpr int NB = 8, SEQ = 8192, MTOK = NB * SEQ, DM = 1024, DFF = 2816, DEPTH = 2;
constexpr int NPROJ = 3840;
constexpr int INW = 3792;
constexpr float RMS_EPS = 1e-6f;
constexpr float LOG2E = 1.4426950408889634f;
constexpr float QSCALE = 0.125f * 1.4426950408889634f;
constexpr float IDX_SCALE = 0.35355339059327373f * 0.125f;
constexpr int AQ_OFF = 0, AK_OFF = 256, AV_OFF = 320, IQ_OFF = 384, IK_OFF = 896, BQ_OFF = 960, BK_OFF = 1216, BV_OFF = 1472,
              CQ_OFF = 1728, CK_OFF = 2240, CV_OFF = 2752, CG_OFF = 3264;
constexpr size_t MiB = 1u << 20;
constexpr size_t WS_CTL = 0, WS_COS = 1 * MiB, WS_SIN = 2 * MiB, WS_IW = 3 * MiB, WS_LF = 5 * MiB, WS_CUM = 7 * MiB, WS_KMEAN = 9 * MiB;
constexpr size_t WS_W = 10 * MiB;
constexpr size_t W_GU_BYTES = (size_t)2 * DFF * DM * 2, W_D_BYTES = (size_t)DM * DFF * 2, W_IN_BYTES = (size_t)NPROJ * DM * 2, W_OUT_BYTES = (size_t)DM * DM * 2;
constexpr size_t WL_GU1 = 0, WL_D1 = WL_GU1 + W_GU_BYTES, WL_GU2 = WL_D1 + W_D_BYTES, WL_D2 = WL_GU2 + W_GU_BYTES, WL_IN = WL_D2 + W_D_BYTES, WL_OUT = WL_IN + W_IN_BYTES,
                 WL_BYTES = WL_OUT + W_OUT_BYTES;
static_assert(WS_W + 2 * WL_BYTES <= 96 * MiB, "weights");
constexpr size_t WS_XN = 96 * MiB, WS_BIG = 224 * MiB, WS_SCR = 704 * MiB, WS_SS = 960 * MiB, WS_END = 984 * MiB;
constexpr size_t WS_HBB = WS_BIG + 352 * MiB;
constexpr size_t SS_STRIDE = (size_t)NB * SEQ * 4;
constexpr int LDS_BYTES = 147456, MISC_OFF = 131072;
constexpr int NTHREADS = 512;

struct Args { const float* in[19]; float* out; unsigned char* ws; int ph_lo, ph_hi; };

__device__ __forceinline__ float bf2f(unsigned short v) { return __uint_as_float((unsigned)v << 16); }
__device__ __forceinline__ unsigned pk2(float lo, float hi) { return pg8::cvt_pk_bf16(lo, hi); }
__device__ __forceinline__ float wave_sum(float v) {
#pragma unroll
    for (int o = 1; o < 64; o <<= 1) v += __shfl_xor(v, o);
    return v;
}
__device__ __forceinline__ float fexp2(float x) { return __builtin_amdgcn_exp2f(x); }
__device__ __forceinline__ float max3f(float a, float b, float c) { float r; asm("v_max3_f32 %0, %1, %2, %3" : "=v"(r) : "v"(a), "v"(b), "v"(c)); return r; }
__device__ __forceinline__ float max2f(float a, float b) { float r; asm("v_max_f32_e32 %0, %1, %2" : "=v"(r) : "v"(a), "v"(b)); return r; }
__device__ __forceinline__ f32x16 mfma32(bf16x8 a, bf16x8 b, f32x16 c) { return __builtin_amdgcn_mfma_f32_32x32x16_bf16(a, b, c, 0, 0, 0); }

__device__ __forceinline__ float row_rscale(const float* SSP, int row) {
    const f32x4* p = (const f32x4*)(SSP + (size_t)row * 16);
    const f32x4 a = p[0], b = p[1], c = p[2], d = p[3];
    const float s = ((a[0] + a[1]) + (a[2] + a[3])) + ((b[0] + b[1]) + (b[2] + b[3])) + ((c[0] + c[1]) + (c[2] + c[3])) + ((d[0] + d[1]) + (d[2] + d[3]));
    return 1.0f / sqrtf(s * (1.0f / DM) + RMS_EPS);
}
struct EpiSwiglu {
    static constexpr bool PERM = true, AFTER_DRAIN = false;
    bf16_t* O; const float* SS;
    __device__ __forceinline__ void operator()(const pg8::f32x4 (&acc)[2][2][4][2], const pg8::Unit& u, int wr, int wc, int fr, int fq) const {
        const int row0 = u.pm * 256 + wr * 64 + fr, col0 = u.pn * 128 + wc * 32 + 8 * fq;
#pragma unroll
        for (int ai = 0; ai < 2; ++ai)
#pragma unroll
            for (int m = 0; m < 4; ++m) {
                float y[8];
                const float rr = row_rscale(SS, row0 + ai * 128 + m * 16);
#pragma unroll
                for (int n = 0; n < 2; ++n)
#pragma unroll
                    for (int i = 0; i < 4; ++i) {
                        const float g = acc[ai][0][m][n][i] * rr, up = acc[ai][1][m][n][i] * rr;
                        const float sg = __builtin_amdgcn_rcpf(1.0f + fexp2(-g * LOG2E));
                        y[4 * n + i] = g * sg * up;
                    }
                u32x4 w; w.x = pk2(y[0], y[1]); w.y = pk2(y[2], y[3]); w.z = pk2(y[4], y[5]); w.w = pk2(y[6], y[7]);
                __builtin_nontemporal_store(w, (u32x4*)(O + (size_t)(row0 + ai * 128 + m * 16) * DFF + col0));
            }
    }
};
template <bool WHB, int ALPHA2>
struct EpiResid {
    static constexpr bool PERM = true, AFTER_DRAIN = false;
    const float* base; float* out; bf16_t* HB; float* SS;
    __device__ __forceinline__ void operator()(const pg8::f32x4 (&acc)[2][2][4][2], const pg8::Unit& u, int wr, int wc, int fr, int fq) const {
        constexpr float alpha = 0.5f * ALPHA2;
        const int row0 = u.pm * 256 + wr * 64 + fr, col0 = u.pn * 256 + wc * 32 + 8 * fq;
#pragma unroll
        for (int ai = 0; ai < 2; ++ai) {
            f32x4 pre[4][2][2];
#pragma unroll
            for (int m = 0; m < 4; ++m)
#pragma unroll
                for (int bj = 0; bj < 2; ++bj) {
                    const size_t ix = (size_t)(row0 + ai * 128 + m * 16) * DM + col0 + bj * 128;
                    pre[m][bj][0] = __builtin_nontemporal_load((const f32x4*)(base + ix)); pre[m][bj][1] = __builtin_nontemporal_load((const f32x4*)(base + ix + 4));
                }
#pragma unroll
            for (int m = 0; m < 4; ++m) {
                const int row = row0 + ai * 128 + m * 16;
                const size_t off = (size_t)row * DM + col0;
                float ssum = 0.f;
#pragma unroll
                for (int bj = 0; bj < 2; ++bj) {
                    const size_t ix = off + bj * 128;
                    const f32x4 b0 = pre[m][bj][0], b1 = pre[m][bj][1];
                    const f32x4 o0 = b0 + acc[ai][bj][m][0] * alpha, o1 = b1 + acc[ai][bj][m][1] * alpha;
                    __builtin_nontemporal_store(o0, (f32x4*)(out + ix)); __builtin_nontemporal_store(o1, (f32x4*)(out + ix + 4));
                    if (WHB) {
                        u32x4 w; w.x = pk2(o0[0], o0[1]); w.y = pk2(o0[2], o0[3]); w.z = pk2(o1[0], o1[1]); w.w = pk2(o1[2], o1[3]);
                        *(u32x4*)(HB + ix) = w;
                        ssum += (o0[0] * o0[0] + o0[1] * o0[1]) + (o0[2] * o0[2] + o0[3] * o0[3]) + (o1[0] * o1[0] + o1[1] * o1[1]) + (o1[2] * o1[2] + o1[3] * o1[3]);
                    }
                }
                if (WHB) {
                    ssum += __shfl_xor(ssum, 16); ssum += __shfl_xor(ssum, 32);
                    if (fq == 0) SS[(size_t)row * 16 + u.pn * 4 + wc] = ssum;
                }
            }
        }
    }
};
struct EpiProj {
    static constexpr bool PERM = true, AFTER_DRAIN = false;
    bf16_t* P; float* IW; float* LF; const float* cosT; const float* sinT;
    const float *gaq, *gak, *gbq, *gbk, *gcq, *gck, *fbias; const float* SS;
    __device__ __forceinline__ void operator()(const pg8::f32x4 (&acc)[2][2][4][2], const pg8::Unit& u, int wr, int wc, int fr, int fq) const {
        const int g = 4 * u.pn + wc;
        const int row0 = u.pm * 256 + wr * 64 + fr;
        if (g == 59) {
            if (fq < 2) {
#pragma unroll
                for (int ai = 0; ai < 2; ++ai)
#pragma unroll
                    for (int m = 0; m < 4; ++m) {
                        const int row = row0 + ai * 128 + m * 16;
                        const float rr = row_rscale(SS, row);
#pragma unroll
                        for (int n = 0; n < 2; ++n) {
                            f32x4 v = acc[ai][0][m][n] * rr;
                            if (fq == 1) {
#pragma unroll
                                for (int i = 0; i < 4; ++i) {
                                    const float x = v[i] + fbias[4 * n + i];
                                    const float ls = (x >= 0.f) ? -log1pf(expf(-x)) : (x - log1pf(expf(x)));
                                    v[i] = ls * LOG2E;
                                }
                                *(f32x4*)(LF + (size_t)row * 8 + 4 * n) = v;
                            } else {
                                *(f32x4*)(IW + (size_t)row * 8 + 4 * n) = v;
                            }
                        }
                    }
            }
            return;
        }
        int mode = 0; const float* gain = gaq;
        if (g < 4) { mode = 1 | 2 | 4; gain = gaq; }
        else if (g == 4) { mode = 1 | 2; gain = gak; }
        else if (g == 5) { mode = 0; }
        else if (g < 15) { mode = 2; }
        else if (g < 19) { mode = 1 | 2 | 4; gain = gbq; }
        else if (g < 23) { mode = 1 | 2; gain = gbk; }
        else if (g < 27) { mode = 0; }
        else if (g < 35) { mode = 1 | 4; gain = gcq; }
        else if (g < 43) { mode = 1; gain = gck; }
        else if (g < 51) { mode = 0; }
        else { mode = 8; }
        f32x4 gn[2][2];
#pragma unroll
        for (int bj = 0; bj < 2; ++bj)
#pragma unroll
            for (int n = 0; n < 2; ++n) gn[bj][n] = (mode & 1) ? *(const f32x4*)(gain + 32 * bj + 8 * fq + 4 * n) : (f32x4){1.f, 1.f, 1.f, 1.f};
        const float qs = (mode & 4) ? QSCALE : 1.0f;
#pragma unroll
        for (int ai = 0; ai < 2; ++ai)
#pragma unroll
            for (int m = 0; m < 4; ++m) {
                const int row = row0 + ai * 128 + m * 16;
                const float rr = row_rscale(SS, row);
                f32x4 v[2][2];
#pragma unroll
                for (int bj = 0; bj < 2; ++bj)
#pragma unroll
                    for (int n = 0; n < 2; ++n) v[bj][n] = acc[ai][bj][m][n] * rr;
                if (mode & 1) {
                    float ss = 0.f;
#pragma unroll
                    for (int bj = 0; bj < 2; ++bj)
#pragma unroll
                        for (int n = 0; n < 2; ++n) ss += (v[bj][n][0] * v[bj][n][0] + v[bj][n][1] * v[bj][n][1]) + (v[bj][n][2] * v[bj][n][2] + v[bj][n][3] * v[bj][n][3]);
                    ss += __shfl_xor(ss, 16); ss += __shfl_xor(ss, 32);
                    const float r = 1.0f / sqrtf(ss * (1.0f / 64.0f) + RMS_EPS);
#pragma unroll
                    for (int bj = 0; bj < 2; ++bj)
#pragma unroll
                        for (int n = 0; n < 2; ++n) v[bj][n] = v[bj][n] * r * gn[bj][n];
                }
                if (mode & 2) {
                    const int pos = row & (SEQ - 1);
#pragma unroll
                    for (int n = 0; n < 2; ++n) {
                        const f32x4 c = *(const f32x4*)(cosT + pos * 32 + 8 * fq + 4 * n), s = *(const f32x4*)(sinT + pos * 32 + 8 * fq + 4 * n);
                        const f32x4 x1 = v[0][n], x2 = v[1][n];
                        v[0][n] = x1 * c - x2 * s; v[1][n] = x2 * c + x1 * s;
                    }
                }
                if (mode & 8) {
#pragma unroll
                    for (int bj = 0; bj < 2; ++bj)
#pragma unroll
                        for (int n = 0; n < 2; ++n)
#pragma unroll
                            for (int i = 0; i < 4; ++i) v[bj][n][i] = 1.0f / (1.0f + __expf(-v[bj][n][i]));
                }
#pragma unroll
                for (int bj = 0; bj < 2; ++bj) {
                    const f32x4 a = v[bj][0] * qs, b = v[bj][1] * qs;
                    u32x4 w; w.x = pk2(a[0], a[1]); w.y = pk2(a[2], a[3]); w.z = pk2(b[0], b[1]); w.w = pk2(b[2], b[3]);
                    __builtin_nontemporal_store(w, (u32x4*)(P + (size_t)row * NPROJ + 64 * g + 32 * bj + 8 * fq));
                }
            }
    }
};

__device__ __forceinline__ int map_row(int kind, int n) {
    if (kind == 0) return n;
    if (kind == 1) return 256 * (n >> 7) + (n & 127);
    if (kind == 2) return 256 * (n >> 7) + 128 + (n & 127);
    int g, d;
    if (n < 384) { g = n >> 6; d = n & 63; }
    else if (n < 960) { g = 6 + ((n - 384) >> 6); d = (n - 384) & 63; }
    else if (n < 968) { g = 59; d = n - 960; }
    else if (n < 3272) { g = 15 + ((n - 968) >> 6); d = (n - 968) & 63; }
    else if (n < 3280) { g = 59; d = 8 + (n - 3272); }
    else { g = 51 + ((n - 3280) >> 6); d = (n - 3280) & 63; }
    return 256 * (g >> 2) + 128 * (d >> 5) + 32 * (g & 3) + (d & 31);
}
__device__ __forceinline__ void transpose_item(const float* W, const float* gain, int K, int N, bf16_t* WT, int kind, float* scr, int item, int lane) {
    const int nblk = (N + 31) / 32, kb = item / nblk, nb = item % nblk, k0 = 64 * kb, n0 = 32 * nb;
    const int n4 = 4 * (lane & 7), nc = n0 + n4;
#pragma unroll
    for (int i = 0; i < 8; ++i) {
        const int kk = 8 * i + (lane >> 3);
        f32x4 v = (nc < N) ? *(const f32x4*)(W + (size_t)(k0 + kk) * N + nc) : (f32x4){0.f, 0.f, 0.f, 0.f};
        if (gain) v = v * gain[k0 + kk];
        scr[kk * 33 + n4] = v[0]; scr[kk * 33 + n4 + 1] = v[1]; scr[kk * 33 + n4 + 2] = v[2]; scr[kk * 33 + n4 + 3] = v[3];
    }
    __builtin_amdgcn_fence(__ATOMIC_RELEASE, "wavefront"); __builtin_amdgcn_wave_barrier(); __builtin_amdgcn_fence(__ATOMIC_ACQUIRE, "wavefront");
    const int c = lane & 7;
#pragma unroll
    for (int j = 0; j < 4; ++j) {
        const int n = (lane >> 3) + 8 * j; const float* s = scr + (8 * c) * 33 + n;
        u32x4 o; o.x = pk2(s[0 * 33], s[1 * 33]); o.y = pk2(s[2 * 33], s[3 * 33]); o.z = pk2(s[4 * 33], s[5 * 33]); o.w = pk2(s[6 * 33], s[7 * 33]);
        if (n0 + n < N) *(u32x4*)(WT + (size_t)map_row(kind, n0 + n) * K + k0 + 8 * c) = o;
    }
    __builtin_amdgcn_fence(__ATOMIC_RELEASE, "wavefront"); __builtin_amdgcn_wave_barrier(); __builtin_amdgcn_fence(__ATOMIC_ACQUIRE, "wavefront");
}
__device__ __forceinline__ void cvt_row(const float* xrow, bf16_t* orow, float* ss, int lane) {
    const f32x4* xr = (const f32x4*)xrow + lane;
    f32x4 v[4]; float s = 0.f;
#pragma unroll
    for (int j = 0; j < 4; ++j) { v[j] = xr[64 * j]; s += (v[j][0] * v[j][0] + v[j][1] * v[j][1]) + (v[j][2] * v[j][2] + v[j][3] * v[j][3]); }
    s = wave_sum(s);
    u32x2* o8 = (u32x2*)orow + lane;
#pragma unroll
    for (int j = 0; j < 4; ++j) { u32x2 w; w.x = pk2(v[j][0], v[j][1]); w.y = pk2(v[j][2], v[j][3]); o8[64 * j] = w; }
    if (lane < 16) ss[lane] = (lane == 0) ? s : 0.f;
}

__device__ __forceinline__ void scan_kmean_phase(const float* LF, float* CUM, const bf16_t* P, float* KMEAN, char* lds) {
    const int tid = threadIdx.x, lane = tid & 63, wave = tid >> 6;
    double* sd = (double*)lds;
    for (int u = blockIdx.x; u < 64; u += gridDim.x) {
        const int b = u >> 3, hh = u & 7;
        const float* src = LF + ((size_t)b * SEQ + 16 * tid) * 8 + hh;
        double loc[16]; double run = 0.0;
#pragma unroll
        for (int e = 0; e < 16; ++e) { run += (double)src[e * 8]; loc[e] = run; }
        __syncthreads();
        sd[tid] = run;
        __syncthreads();
        for (int off = 1; off < 512; off <<= 1) {
            const double v = (tid >= off) ? sd[tid - off] : 0.0;
            __syncthreads();
            sd[tid] += v;
            __syncthreads();
        }
        const double base = (tid > 0) ? sd[tid - 1] : 0.0;
        float* dst = CUM + ((size_t)b * SEQ + 16 * tid) * 8 + hh;
#pragma unroll
        for (int e = 0; e < 16; ++e) dst[e * 8] = (float)(base + loc[e]);
        __syncthreads();
    }
    const bool split = gridDim.x >= 128;
    if (split && blockIdx.x < 64) return;
    const int gw = (split ? (int)blockIdx.x - 64 : (int)blockIdx.x) * 8 + wave, ngw = (split ? (int)gridDim.x - 64 : (int)gridDim.x) * 8;
    for (int u = gw; u < NB * 4 * 32; u += ngw) {
        const int b = u >> 7, h = (u >> 5) & 3, blk = u & 31;
        const bf16_t* src = P + ((size_t)b * SEQ + 256 * blk + (lane >> 3)) * NPROJ + BK_OFF + 64 * h + 8 * (lane & 7);
        float acc[8];
#pragma unroll
        for (int e = 0; e < 8; ++e) acc[e] = 0.f;
#pragma unroll 8
        for (int i = 0; i < 32; ++i) {
            const u32x4 v = *(const u32x4*)(src + (size_t)(8 * i) * NPROJ);
            acc[0] += __uint_as_float(v.x << 16); acc[1] += __uint_as_float(v.x & 0xffff0000u);
            acc[2] += __uint_as_float(v.y << 16); acc[3] += __uint_as_float(v.y & 0xffff0000u);
            acc[4] += __uint_as_float(v.z << 16); acc[5] += __uint_as_float(v.z & 0xffff0000u);
            acc[6] += __uint_as_float(v.w << 16); acc[7] += __uint_as_float(v.w & 0xffff0000u);
        }
#pragma unroll
        for (int e = 0; e < 8; ++e) { acc[e] += __shfl_xor(acc[e], 8); acc[e] += __shfl_xor(acc[e], 16); acc[e] += __shfl_xor(acc[e], 32); }
        if (lane < 8) {
            f32x4 o0v, o1v;
            o0v[0] = acc[0] * (1.0f / 256.0f); o0v[1] = acc[1] * (1.0f / 256.0f); o0v[2] = acc[2] * (1.0f / 256.0f); o0v[3] = acc[3] * (1.0f / 256.0f);
            o1v[0] = acc[4] * (1.0f / 256.0f); o1v[1] = acc[5] * (1.0f / 256.0f); o1v[2] = acc[6] * (1.0f / 256.0f); o1v[3] = acc[7] * (1.0f / 256.0f);
            *(f32x4*)(KMEAN + (size_t)u * 64 + 8 * lane) = o0v; *(f32x4*)(KMEAN + (size_t)u * 64 + 8 * lane + 4) = o1v;
        }
    }
}

constexpr int KS_LD = 72, VT_LD = 68;
constexpr int FL_KS = 0, FL_VT = FL_KS + 64 * KS_LD * 2, FL_CK = FL_VT + 64 * VT_LD * 2, FL_BUF = FL_CK + 256, FL_END = 2 * FL_BUF;
template <int MODE>
__device__ __forceinline__ void flash_unit(const bf16_t* __restrict__ P, const float* __restrict__ CUM, const float* __restrict__ KMEAN, bf16_t* __restrict__ MIX,
                                           const float* __restrict__ gq, const float* __restrict__ gk, int b, int h, int qt, char* lds) {
    int tid_ = threadIdx.x; asm volatile("" : "+v"(tid_));
    const int tid = tid_, lane = tid & 63, w = __builtin_amdgcn_readfirstlane(tid >> 6), l32 = lane & 31, hi = lane >> 5;
    constexpr int QOFF = MODE == 0 ? CQ_OFF : BQ_OFF, KOFF = MODE == 0 ? CK_OFF : BK_OFF, VOFF = MODE == 0 ? CV_OFF : BV_OFF, OOFF = MODE == 0 ? 512 : 256;
    unsigned* umask = (unsigned*)(lds + FL_END);
    const size_t rowbase = (size_t)b * SEQ;
    const int q0 = qt * 256 + w * 32, myq = q0 + l32;
    const bf16_t* qrow = P + (rowbase + myq) * NPROJ + QOFF + 64 * h;
    bf16x8 qf[4];
#pragma unroll
    for (int ks = 0; ks < 4; ++ks) qf[ks] = *(const bf16x8*)(qrow + 16 * ks + 8 * hi);
    unsigned selmask = 0, unionmask = 0xffffffffu;
    if (MODE == 1) {
        float v1 = -INFINITY, v2 = -INFINITY, v3 = -INFINITY; int i1 = -1, i2 = -1, i3 = -1;
        const float* km = KMEAN + ((size_t)(b * 4 + h) * 32) * 64;
        for (int n = 0; n < qt; ++n) {
            float gsum = 0.f;
#pragma unroll
            for (int c8 = 0; c8 < 8; ++c8) {
                const u32x4 qv = *(const u32x4*)(qrow + 8 * c8);
                const f32x4 k0 = *(const f32x4*)(km + n * 64 + 8 * c8), k1 = *(const f32x4*)(km + n * 64 + 8 * c8 + 4);
                gsum += __uint_as_float(qv.x << 16) * k0[0] + __uint_as_float(qv.x & 0xffff0000u) * k0[1] + __uint_as_float(qv.y << 16) * k0[2] + __uint_as_float(qv.y & 0xffff0000u) * k0[3]
                      + __uint_as_float(qv.z << 16) * k1[0] + __uint_as_float(qv.z & 0xffff0000u) * k1[1] + __uint_as_float(qv.w << 16) * k1[2] + __uint_as_float(qv.w & 0xffff0000u) * k1[3];
            }
            if (gsum > v3) {
                if (gsum > v1) { v3 = v2; i3 = i2; v2 = v1; i2 = i1; v1 = gsum; i1 = n; }
                else if (gsum > v2) { v3 = v2; i3 = i2; v2 = gsum; i2 = n; }
                else { v3 = gsum; i3 = n; }
            }
        }
        if (i1 >= 0) selmask |= 1u << i1;
        if (i2 >= 0) selmask |= 1u << i2;
        if (i3 >= 0) selmask |= 1u << i3;
        __syncthreads();
        if (tid == 0) *umask = 0u;
        __syncthreads();
        unsigned wm = selmask;
#pragma unroll
        for (int o = 1; o < 64; o <<= 1) wm |= __shfl_xor(wm, o);
        if (lane == 0) atomicOr(umask, wm);
        __syncthreads();
        unionmask = *umask;
    }
    float cref = 0.f;
    if (MODE == 0) cref = CUM[(rowbase + qt * 256) * 8 + h];
    float m = -INFINITY, lsum = 0.f;
    f32x16 o0, o1;
#pragma unroll
    for (int r = 0; r < 16; ++r) { o0[r] = 0.f; o1[r] = 0.f; }
    const int NT = 4 * qt + 4;
    const int kkey = tid >> 3, kch = tid & 7;
    const int vkey = 16 * (w & 3) + (lane & 15), vch = 4 * (w >> 2) + (lane >> 4);
    int kt = 0;
    if (MODE == 1) { while (kt < 4 * qt && !((unionmask >> (kt >> 2)) & 1u)) ++kt; }
    if (MODE == 0) {
        float gqm = fabsf(gq[lane]), gkm = fabsf(gk[lane]);
#pragma unroll
        for (int o = 1; o < 64; o <<= 1) { gqm = fmaxf(gqm, __shfl_xor(gqm, o)); gkm = fmaxf(gkm, __shfl_xor(gkm, o)); }
        const float margin = 2.0f * (64.0f * gqm * gkm * QSCALE * 1.02f) + 40.0f;
        bool skip = false;
        if (tid < 4 * qt) skip = (cref - CUM[(rowbase + 64 * tid + 63) * 8 + h]) < -margin;
        kt = __syncthreads_count(skip ? 1 : 0);
    }
    u32x4 kreg, vreg; float creg = 0.f;
#define FL_LOAD(kt_) do { kreg = *(const u32x4*)(P + (rowbase + 64 * (kt_) + kkey) * NPROJ + KOFF + 64 * h + 8 * kch); \
        vreg = *(const u32x4*)(P + (rowbase + 64 * (kt_) + vkey) * NPROJ + VOFF + 64 * h + 8 * vch); \
        if (MODE == 0 && tid < 64) creg = cref - CUM[(rowbase + 64 * (kt_) + tid) * 8 + h]; } while (0)
#define FL_STORE(buf_) do { bf16_t* Kd_ = (bf16_t*)(lds + (buf_) * FL_BUF + FL_KS); bf16_t* Vd_ = (bf16_t*)(lds + (buf_) * FL_BUF + FL_VT); \
        *(u32x4*)(Kd_ + kkey * KS_LD + 8 * kch) = kreg; \
        bf16_t* vd = Vd_ + (8 * vch) * VT_LD + vkey; \
        vd[0 * VT_LD] = (bf16_t)(vreg.x & 0xffffu); vd[1 * VT_LD] = (bf16_t)(vreg.x >> 16); \
        vd[2 * VT_LD] = (bf16_t)(vreg.y & 0xffffu); vd[3 * VT_LD] = (bf16_t)(vreg.y >> 16); \
        vd[4 * VT_LD] = (bf16_t)(vreg.z & 0xffffu); vd[5 * VT_LD] = (bf16_t)(vreg.z >> 16); \
        vd[6 * VT_LD] = (bf16_t)(vreg.w & 0xffffu); vd[7 * VT_LD] = (bf16_t)(vreg.w >> 16); \
        if (MODE == 0 && tid < 64) ((float*)(lds + (buf_) * FL_BUF + FL_CK))[tid] = creg; } while (0)
    FL_LOAD(kt);
    __syncthreads();
    FL_STORE(0);
    __syncthreads();
    int cur = 0;
    while (kt < NT) {
        const int ktc = kt;
        int ktn = kt + 1;
        if (MODE == 1) { while (ktn < 4 * qt && !((unionmask >> (ktn >> 2)) & 1u)) ++ktn; }
        if (ktn < NT) FL_LOAD(ktn);
        kt = ktn;
        const bf16_t* Ks = (const bf16_t*)(lds + cur * FL_BUF + FL_KS); const bf16_t* VT = (const bf16_t*)(lds + cur * FL_BUF + FL_VT);
        const float* cks = (const float*)(lds + cur * FL_BUF + FL_CK);
        if (!(64 * ktc > q0 + 31)) {
        f32x16 s0, s1;
#pragma unroll
        for (int r = 0; r < 16; ++r) { s0[r] = 0.f; s1[r] = 0.f; }
#pragma unroll
        for (int ks = 0; ks < 4; ++ks) {
            const bf16x8 a0 = *(const bf16x8*)(Ks + l32 * KS_LD + 16 * ks + 8 * hi);
            const bf16x8 a1 = *(const bf16x8*)(Ks + (32 + l32) * KS_LD + 16 * ks + 8 * hi);
            s0 = mfma32(a0, qf[ks], s0); s1 = mfma32(a1, qf[ks], s1);
        }
        if (MODE == 0) {
#pragma unroll
            for (int g = 0; g < 4; ++g) {
                const f32x4 c0 = *(const f32x4*)(cks + 8 * g + 4 * hi), c1 = *(const f32x4*)(cks + 32 + 8 * g + 4 * hi);
#pragma unroll
                for (int i = 0; i < 4; ++i) { s0[4 * g + i] += c0[i]; s1[4 * g + i] += c1[i]; }
            }
        }
        if (MODE == 1 && ktc < 4 * qt) {
            if (!((selmask >> (ktc >> 2)) & 1u)) {
#pragma unroll
                for (int r = 0; r < 16; ++r) { s0[r] = -INFINITY; s1[r] = -INFINITY; }
            }
        }
        if (64 * ktc + 63 > q0) {
#pragma unroll
            for (int r = 0; r < 16; ++r) {
                const int kg = 64 * ktc + 8 * (r >> 2) + 4 * hi + (r & 3);
                if (kg > myq) s0[r] = -INFINITY;
                if (kg + 32 > myq) s1[r] = -INFINITY;
            }
        }
        float mxa = max3f(s0[0], s0[1], s0[2]), mxb = max3f(s1[0], s1[1], s1[2]);
#pragma unroll
        for (int r = 3; r < 15; r += 2) { mxa = max3f(mxa, s0[r], s0[r + 1]); mxb = max3f(mxb, s1[r], s1[r + 1]); }
        float mx = max3f(mxa, mxb, s0[15]); mx = max2f(mx, s1[15]);
        mx = max2f(mx, __shfl_xor(mx, 32));
        const float mnew = max2f(m, mx);
        const float msafe = (mnew == -INFINITY) ? 0.f : mnew;
        const float alpha = fexp2(m - msafe);
        float psum = 0.f;
#pragma unroll
        for (int r = 0; r < 16; ++r) { s0[r] = fexp2(s0[r] - msafe); s1[r] = fexp2(s1[r] - msafe); psum += s0[r] + s1[r]; }
        lsum = lsum * alpha + psum; m = mnew;
#pragma unroll
        for (int r = 0; r < 16; ++r) { o0[r] *= alpha; o1[r] *= alpha; }
        bf16x8 pk[4];
        {
            u32x4 t;
            t.x = pk2(s0[0], s0[1]); t.y = pk2(s0[2], s0[3]); t.z = pk2(s0[4], s0[5]); t.w = pk2(s0[6], s0[7]); pk[0] = __builtin_bit_cast(bf16x8, t);
            t.x = pk2(s0[8], s0[9]); t.y = pk2(s0[10], s0[11]); t.z = pk2(s0[12], s0[13]); t.w = pk2(s0[14], s0[15]); pk[1] = __builtin_bit_cast(bf16x8, t);
            t.x = pk2(s1[0], s1[1]); t.y = pk2(s1[2], s1[3]); t.z = pk2(s1[4], s1[5]); t.w = pk2(s1[6], s1[7]); pk[2] = __builtin_bit_cast(bf16x8, t);
            t.x = pk2(s1[8], s1[9]); t.y = pk2(s1[10], s1[11]); t.z = pk2(s1[12], s1[13]); t.w = pk2(s1[14], s1[15]); pk[3] = __builtin_bit_cast(bf16x8, t);
        }
#pragma unroll
        for (int kk = 0; kk < 4; ++kk) {
            u32x4 a, c;
            const u32x2 a_lo = *(const u32x2*)(VT + l32 * VT_LD + 16 * kk + 4 * hi), a_hi = *(const u32x2*)(VT + l32 * VT_LD + 16 * kk + 8 + 4 * hi);
            const u32x2 c_lo = *(const u32x2*)(VT + (32 + l32) * VT_LD + 16 * kk + 4 * hi), c_hi = *(const u32x2*)(VT + (32 + l32) * VT_LD + 16 * kk + 8 + 4 * hi);
            a.x = a_lo.x; a.y = a_lo.y; a.z = a_hi.x; a.w = a_hi.y; c.x = c_lo.x; c.y = c_lo.y; c.z = c_hi.x; c.w = c_hi.y;
            o0 = mfma32(__builtin_bit_cast(bf16x8, a), pk[kk], o0);
            o1 = mfma32(__builtin_bit_cast(bf16x8, c), pk[kk], o1);
        }
        }
        if (kt < NT) FL_STORE(cur ^ 1);
        __syncthreads();
        cur ^= 1;
    }
#undef FL_LOAD
#undef FL_STORE
    const float ltot = lsum + __shfl_xor(lsum, 32);
    const float inv = 1.0f / ltot;
    bf16_t* orow = MIX + (rowbase + myq) * DM + OOFF + 64 * h;
    const bf16_t* grow = P + (rowbase + myq) * NPROJ + CG_OFF + 64 * h;
#pragma unroll
    for (int g = 0; g < 4; ++g) {
        const int d = 8 * g + 4 * hi;
        float a0 = o0[4 * g] * inv, a1 = o0[4 * g + 1] * inv, a2 = o0[4 * g + 2] * inv, a3 = o0[4 * g + 3] * inv;
        float c0 = o1[4 * g] * inv, c1 = o1[4 * g + 1] * inv, c2 = o1[4 * g + 2] * inv, c3 = o1[4 * g + 3] * inv;
        if (MODE == 0) {
            const u32x2 ga = *(const u32x2*)(grow + d), gc = *(const u32x2*)(grow + 32 + d);
            a0 *= __uint_as_float(ga.x << 16); a1 *= __uint_as_float(ga.x & 0xffff0000u); a2 *= __uint_as_float(ga.y << 16); a3 *= __uint_as_float(ga.y & 0xffff0000u);
            c0 *= __uint_as_float(gc.x << 16); c1 *= __uint_as_float(gc.x & 0xffff0000u); c2 *= __uint_as_float(gc.y << 16); c3 *= __uint_as_float(gc.y & 0xffff0000u);
        }
        u32x2 wa, wc2; wa.x = pk2(a0, a1); wa.y = pk2(a2, a3); wc2.x = pk2(c0, c1); wc2.y = pk2(c2, c3);
        *(u32x2*)(orow + d) = wa; *(u32x2*)(orow + 32 + d) = wc2;
    }
    __syncthreads();
}

constexpr int KI_LD = 72;
constexpr int VTD_LD = 72, PW_LD = 256;
constexpr int SEL_CAP = 512, CMP_CAP = 768;
constexpr int DS_KI = 0, DS_VT = 0, DS_LIST = 8 * 64 * VTD_LD * 2, DS_PW = DS_LIST + 8 * 512, DS_CK = DS_PW + 8 * 4 * PW_LD * 2, DS_CI = DS_CK + 8 * CMP_CAP * 4, DS_END = DS_CI + 8 * CMP_CAP * 2;
static_assert(512 * KI_LD * 2 <= DS_LIST && DS_END <= 131072, "DSA LDS map");
typedef short v4i16_t __attribute__((ext_vector_type(4)));
__device__ __forceinline__ v4i16_t ds_tr16(const void* p) { return __builtin_amdgcn_ds_read_tr16_b64_v4i16((__attribute__((address_space(3))) v4i16_t*)p); }
__device__ __forceinline__ void dsa_unit(const bf16_t* __restrict__ P, const float* __restrict__ IW, bf16_t* __restrict__ MIX, float* __restrict__ scr, int b, int tile, char* lds) {
    int tid_ = threadIdx.x; asm volatile("" : "+v"(tid_));
    const int tid = tid_, lane = tid & 63, w = __builtin_amdgcn_readfirstlane(tid >> 6), l32 = lane & 31, hi = lane >> 5;
    bf16_t* KI = (bf16_t*)(lds + DS_KI);
    unsigned short* LIST = (unsigned short*)(lds + DS_LIST) + w * 256;
    bf16_t* PWb = (bf16_t*)(lds + DS_PW) + w * 4 * PW_LD;
    bf16_t* Vt = (bf16_t*)(lds + DS_VT) + w * 64 * VTD_LD;
    unsigned* CK = (unsigned*)(lds + DS_CK) + w * CMP_CAP; unsigned short* CI = (unsigned short*)(lds + DS_CI) + w * CMP_CAP;
    const size_t rowbase = (size_t)b * SEQ;
    const int t0 = 32 * tile;
#ifdef PROBE_SCORE2
#pragma unroll 1
    for (int rep_ = 0; rep_ < 2; ++rep_)
#endif
    {
        const int qsel = ((l32 >> 4) & 1) + 2 * ((l32 >> 2) & 1), head = (l32 & 3) + 4 * ((l32 >> 3) & 1);
        const bf16_t* arow = P + (rowbase + t0 + 4 * w + qsel) * NPROJ + IQ_OFF + 64 * head + 8 * hi;
        bf16x8 af[4];
#pragma unroll
        for (int ks = 0; ks < 4; ++ks) af[ks] = *(const bf16x8*)(arow + 16 * ks);
        float wA[8], wB[8];
        {
            const float* wa = IW + (rowbase + t0 + 4 * w + 2 * hi) * 8;
#pragma unroll
            for (int hh = 0; hh < 8; ++hh) { wA[hh] = wa[hh] * IDX_SCALE; wB[hh] = wa[8 + hh] * IDX_SCALE; }
        }
        const int nkt = tile + 1, nchunk = (nkt + 15) >> 4;
        float* sA = scr + (size_t)(4 * w + 2 * hi) * SEQ; float* sB = sA + SEQ;
        u32x4 stg[8];
        const bf16_t* kisrc = P + (rowbase + (tid >> 3)) * NPROJ + IK_OFF + 8 * (tid & 7);
#pragma unroll
        for (int i8 = 0; i8 < 8; ++i8) stg[i8] = *(const u32x4*)(kisrc + (size_t)(64 * i8) * NPROJ);
#pragma unroll 1
        for (int c = 0; c < nchunk; ++c) {
            __syncthreads();
#pragma unroll
            for (int i8 = 0; i8 < 8; ++i8) *(u32x4*)(KI + ((tid >> 3) + 64 * i8) * KI_LD + 8 * (tid & 7)) = stg[i8];
            __syncthreads();
            if (c + 1 < nchunk) {
#pragma unroll
                for (int i8 = 0; i8 < 8; ++i8) stg[i8] = *(const u32x4*)(kisrc + (size_t)(512 * (c + 1) + 64 * i8) * NPROJ);
            }
            const int ntl = (nkt - 16 * c) < 16 ? (nkt - 16 * c) : 16;
#define SCORE_MMA(D_, k8_) do { _Pragma("unroll") for (int r_ = 0; r_ < 16; ++r_) D_[r_] = 0.f; \
                _Pragma("unroll") for (int ks_ = 0; ks_ < 4; ++ks_) D_ = mfma32(af[ks_], *(const bf16x8*)(KI + (32 * (k8_) + l32) * KI_LD + 16 * ks_ + 8 * hi), D_); } while (0)
#define SCORE_OUT(D_, k8_) do { float a_ = 0.f, b_ = 0.f; \
                _Pragma("unroll") for (int hh_ = 0; hh_ < 8; ++hh_) { a_ = __builtin_fmaf(wA[hh_], __builtin_amdgcn_fmed3f(D_[hh_], 0.f, __builtin_inff()), a_); \
                                                                     b_ = __builtin_fmaf(wB[hh_], __builtin_amdgcn_fmed3f(D_[8 + hh_], 0.f, __builtin_inff()), b_); } \
                const int key_ = 512 * c + 32 * (k8_) + l32; \
                const int ba_ = (int)__float_as_uint(a_ + 0.0f), bb_ = (int)__float_as_uint(b_ + 0.0f); \
                __builtin_nontemporal_store(__uint_as_float((unsigned)ba_ ^ ((unsigned)(ba_ >> 31) | 0x80000000u)), sA + key_); \
                __builtin_nontemporal_store(__uint_as_float((unsigned)bb_ ^ ((unsigned)(bb_ >> 31) | 0x80000000u)), sB + key_); } while (0)
            int k8 = 0;
#pragma unroll 1
            for (; k8 + 3 < ntl; k8 += 4) {
                f32x16 D0, D1, D2, D3;
                SCORE_MMA(D0, k8); SCORE_MMA(D1, k8 + 1); SCORE_MMA(D2, k8 + 2); SCORE_MMA(D3, k8 + 3);
                SCORE_OUT(D0, k8); SCORE_OUT(D1, k8 + 1); SCORE_OUT(D2, k8 + 2); SCORE_OUT(D3, k8 + 3);
            }
#pragma unroll 1
            for (; k8 < ntl; ++k8) { f32x16 D0; SCORE_MMA(D0, k8); SCORE_OUT(D0, k8); }
#undef SCORE_MMA
#undef SCORE_OUT
        }
    }
    __syncthreads();
    __builtin_amdgcn_fence(__ATOMIC_ACQUIRE, "agent");
    int eg = 127;
#pragma unroll 1
    for (int qq = 0; qq < 4; ++qq) {
        const int t = t0 + 4 * w + qq, n = t + 1;
        const size_t row = rowbase + t;
        int lane = threadIdx.x & 63; asm volatile("" : "+v"(lane));
        const float* srow = scr + (size_t)(4 * w + qq) * SEQ + lane;
        asm volatile("" : "+v"(srow));
        int cnt;
        if (n <= 256) {
            cnt = n;
            for (int j = lane; j < n; j += 64) LIST[j] = (unsigned short)j;
        } else {
            cnt = 256;
            unsigned v[128];
#pragma unroll
            for (int g = 0; g < 8; ++g) {
                if ((g + 1) * 1024 <= n) {
#pragma unroll
                    for (int jj = 0; jj < 16; ++jj) v[g * 16 + jj] = __float_as_uint(__builtin_nontemporal_load(srow + (g * 16 + jj) * 64));
                    asm volatile("" ::: "memory");
                } else if (g * 1024 < n) {
                    int lb = lane; asm volatile("" : "+v"(lb));
#pragma unroll
                    for (int jj = 0; jj < 16; ++jj) {
                        const int idx = (g * 16 + jj) * 64 + lb;
                        v[g * 16 + jj] = (idx < n) ? __float_as_uint(__builtin_nontemporal_load(srow + (g * 16 + jj) * 64)) : 0u;
                    }
                    asm volatile("" ::: "memory");
                } else {
#pragma unroll
                    for (int jj = 0; jj < 16; ++jj) v[g * 16 + jj] = 0u;
                }
            }
            unsigned T = 0u; int cT = n, cU = 0; int bit = 31; bool exact = false;
            if (n > 1024) {
                unsigned probe = 0x80000000u | ((unsigned)eg << 23);
                int cp = 0;
#pragma unroll
                for (int g = 0; g < 8; ++g) {
                    if (g * 1024 < n) {
#pragma unroll
                        for (int jj = 0; jj < 16; ++jj) cp += __builtin_popcountll(__ballot(v[g * 16 + jj] >= probe));
                    }
                }
                const bool up = cp >= 256;
#pragma unroll 1
                for (int tr = 0; tr < 3; ++tr) {
                    const unsigned p2 = up ? probe + (1u << 23) : probe - (1u << 23);
                    int c2 = 0;
#pragma unroll
                    for (int g = 0; g < 8; ++g) {
                        if (g * 1024 < n) {
#pragma unroll
                            for (int jj = 0; jj < 16; ++jj) c2 += __builtin_popcountll(__ballot(v[g * 16 + jj] >= p2));
                        }
                    }
                    if (up ? (c2 < 256) : (c2 >= 256)) {
                        T = up ? probe : p2; cT = up ? cp : c2; cU = up ? c2 : cp; bit = 22;
                        if (cT == 256) exact = true;
                        break;
                    }
                    probe = p2; cp = c2;
                }
            }
#pragma unroll 1
            while (!exact && bit >= 0 && (cT - cU) > SEL_CAP) {
                const unsigned cand = T | (1u << bit);
                int c = 0;
#pragma unroll
                for (int g = 0; g < 8; ++g) {
                    if (g * 1024 < n) {
#pragma unroll
                        for (int jj = 0; jj < 16; ++jj) c += __builtin_popcountll(__ballot(v[g * 16 + jj] >= cand));
                    }
                }
                --bit;
                if (c >= 256) { T = cand; cT = c; if (c == 256) { exact = true; break; } }
                else { cU = c; }
            }
            if (exact) {
                int pos = 0;
#pragma unroll
                for (int g = 0; g < 8; ++g) {
                    if (g * 1024 < n) {
                        int lb = lane; asm volatile("" : "+v"(lb));
#pragma unroll
                        for (int jj = 0; jj < 16; ++jj) {
                            const unsigned x = v[g * 16 + jj]; const int idx = (g * 16 + jj) * 64 + lb;
                            const bool gt = x >= T; const unsigned long long mg = __ballot(gt);
                            const int pre = __builtin_amdgcn_mbcnt_hi((unsigned)(mg >> 32), __builtin_amdgcn_mbcnt_lo((unsigned)mg, 0u));
                            if (gt) LIST[pos + pre] = (unsigned short)idx;
                            pos += __builtin_popcountll(mg);
                        }
                    }
                }
            } else {
                int bpos = 0;
                const unsigned Tb = T ? T : 1u;
                if (cT <= CMP_CAP) {
#pragma unroll
                for (int g = 0; g < 8; ++g) {
                    if (g * 1024 < n) {
                        int lb = lane; asm volatile("" : "+v"(lb));
#pragma unroll
                        for (int jj = 0; jj < 16; ++jj) {
                            const unsigned x = v[g * 16 + jj]; const int idx = (g * 16 + jj) * 64 + lb;
                            const bool inb = (x >= Tb); const unsigned long long mb = __ballot(inb);
                            const int pb = __builtin_amdgcn_mbcnt_hi((unsigned)(mb >> 32), __builtin_amdgcn_mbcnt_lo((unsigned)mb, 0u));
                            if (inb) { CK[bpos + pb] = x; CI[bpos + pb] = (unsigned short)idx; }
                            bpos += __builtin_popcountll(mb);
                        }
                    }
                }
                } else {
#pragma unroll
                for (int g = 0; g < 8; ++g) {
                    if (g * 1024 < n) {
                        int lb = lane; asm volatile("" : "+v"(lb));
#pragma unroll
                        for (int jj = 0; jj < 16; ++jj) {
                            const unsigned x = v[g * 16 + jj]; const int idx = (g * 16 + jj) * 64 + lb;
                            const bool inb = (x >= Tb); const unsigned long long mb = __ballot(inb);
                            const int pb = __builtin_amdgcn_mbcnt_hi((unsigned)(mb >> 32), __builtin_amdgcn_mbcnt_lo((unsigned)mb, 0u));
                            if (inb && (bpos + pb) < CMP_CAP) { CK[bpos + pb] = x; CI[bpos + pb] = (unsigned short)idx; }
                            bpos += __builtin_popcountll(mb);
                        }
                    }
                }
                }
                asm volatile("s_waitcnt lgkmcnt(0)" ::: "memory");
                __builtin_amdgcn_wave_barrier();
                const int mall = cT < CMP_CAP ? cT : CMP_CAP;
                unsigned cv[CMP_CAP / 64];
#pragma unroll
                for (int e = 0; e < CMP_CAP / 64; ++e) { const int p = e * 64 + lane; cv[e] = (p < mall) ? CK[p] : 0u; }
                bool exact2 = false;
#pragma unroll 1
                for (; bit >= 0; --bit) {
                    const unsigned cand = T | (1u << bit);
                    int c = 0;
#pragma unroll
                    for (int e = 0; e < CMP_CAP / 64; ++e) c += __builtin_popcountll(__ballot(cv[e] >= cand));
                    if (c >= 256) { T = cand; if (c == 256) { exact2 = true; break; } }
                }
                const unsigned Tg = exact2 ? (T - 1u) : T;
                int Gb = 0;
#pragma unroll
                for (int e = 0; e < CMP_CAP / 64; ++e) Gb += __builtin_popcountll(__ballot(cv[e] > Tg));
                const int E = exact2 ? 0 : (256 - Gb);
                int gpos = 0, eqseen = 0;
#pragma unroll
                for (int e = 0; e < CMP_CAP / 64; ++e) {
                    const int p = e * 64 + lane; const unsigned x = cv[e];
                    const unsigned short ci = CI[p < mall ? p : 0];
                    const bool gt = x > Tg; const unsigned long long mg = __ballot(gt);
                    const int pre = __builtin_amdgcn_mbcnt_hi((unsigned)(mg >> 32), __builtin_amdgcn_mbcnt_lo((unsigned)mg, 0u));
                    if (gt) LIST[gpos + pre] = ci;
                    gpos += __builtin_popcountll(mg);
                    const bool eq = (!exact2) && (x == T) && (p < mall); const unsigned long long me = __ballot(eq);
                    const int pe = __builtin_amdgcn_mbcnt_hi((unsigned)(me >> 32), __builtin_amdgcn_mbcnt_lo((unsigned)me, 0u));
                    if (eq && (eqseen + pe) < E) LIST[Gb + eqseen + pe] = ci;
                    eqseen += __builtin_popcountll(me);
                }
            }
            if (T >= 0x80800000u) { const int e_ = (int)((T >> 23) & 0xffu); eg = e_ < 4 ? 4 : (e_ > 250 ? 250 : e_); }
        }
        __builtin_amdgcn_fence(__ATOMIC_RELEASE, "wavefront"); __builtin_amdgcn_wave_barrier(); __builtin_amdgcn_fence(__ATOMIC_ACQUIRE, "wavefront");
#ifdef PROBE_ATTN2
#pragma unroll 1
        for (int rep_ = 0; rep_ < 2; ++rep_) {
#else
        {
#endif
        int ln = lane; asm volatile("" : "+v"(ln));
        const int l32a = ln & 31, hia = ln >> 5;
        bf16x8 aq[4];
        {
            const bf16_t* qr = P + row * NPROJ + AQ_OFF + 64 * (l32a & 3) + 8 * hia;
#pragma unroll
            for (int ks = 0; ks < 4; ++ks) {
                bf16x8 z = *(const bf16x8*)(qr + 16 * ks);
                if (l32a >= 4) z = (bf16x8){0, 0, 0, 0, 0, 0, 0, 0};
                aq[ks] = z;
            }
        }
        const bf16_t* kbase = P + rowbase * NPROJ + AK_OFF + 8 * hia;
        const bf16_t* vgbase = P + rowbase * NPROJ + AV_OFF + 8 * (ln & 7);
        u32x4 vr[8];
#define DSA_VLOAD(vt) do { _Pragma("unroll") for (int i_ = 0; i_ < 8; ++i_) { const int j_ = 64 * (vt) + 8 * i_ + (ln >> 3); \
            const int idx_ = (j_ < cnt) ? (int)LIST[j_] : 0; vr[i_] = *(const u32x4*)(vgbase + (size_t)idx_ * NPROJ); } } while (0)
        DSA_VLOAD(0);
        float sc[8][4];
        const int ntile = (cnt + 31) >> 5;
#pragma unroll
        for (int grp = 0; grp < 2; ++grp) {
            if (grp * 4 < ntile) {
                bf16x8 kb[4][4];
#pragma unroll
                for (int k4 = 0; k4 < 4; ++k4) {
                    const int j = 32 * (4 * grp + k4) + l32a;
                    const int idx = (j < cnt) ? (int)LIST[j] : 0;
                    const bf16_t* kr = kbase + (size_t)idx * NPROJ;
#pragma unroll
                    for (int ks = 0; ks < 4; ++ks) kb[k4][ks] = *(const bf16x8*)(kr + 16 * ks);
                }
#pragma unroll
                for (int k4 = 0; k4 < 4; ++k4) {
                    const int j = 32 * (4 * grp + k4) + l32a;
                    f32x16 D;
#pragma unroll
                    for (int r = 0; r < 16; ++r) D[r] = 0.f;
#pragma unroll
                    for (int ks = 0; ks < 4; ++ks) D = mfma32(aq[ks], kb[k4][ks], D);
                    const bool ok = (j < cnt) && (hia == 0);
#pragma unroll
                    for (int hh = 0; hh < 4; ++hh) sc[4 * grp + k4][hh] = ok ? D[hh] : -INFINITY;
                }
            } else {
#pragma unroll
                for (int k4 = 0; k4 < 4; ++k4)
#pragma unroll
                    for (int hh = 0; hh < 4; ++hh) sc[4 * grp + k4][hh] = -INFINITY;
            }
        }
        float lh[4];
#pragma unroll
        for (int hh = 0; hh < 4; ++hh) {
            float mx = sc[0][hh];
#pragma unroll
            for (int kt = 1; kt < 8; ++kt) mx = fmaxf(mx, sc[kt][hh]);
#pragma unroll
            for (int o = 1; o < 32; o <<= 1) mx = fmaxf(mx, __shfl_xor(mx, o));
            const float ms = (mx == -INFINITY) ? 0.f : mx;
            float sm = 0.f;
#pragma unroll
            for (int kt = 0; kt < 8; ++kt) { sc[kt][hh] = fexp2(sc[kt][hh] - ms); sm += sc[kt][hh]; }
#pragma unroll
            for (int o = 1; o < 32; o <<= 1) sm += __shfl_xor(sm, o);
            sm += __shfl_xor(sm, 32);
            lh[hh] = sm;
        }
        if (hia == 0) {
#pragma unroll
            for (int hh = 0; hh < 4; ++hh)
#pragma unroll
                for (int kt = 0; kt < 8; ++kt) PWb[hh * PW_LD + 32 * kt + l32a] = (bf16_t)(pk2(sc[kt][hh], 0.f) & 0xffffu);
        }
        asm volatile("s_waitcnt lgkmcnt(0)" ::: "memory");
        __builtin_amdgcn_wave_barrier();
        f32x16 oA, oB;
#pragma unroll
        for (int r = 0; r < 16; ++r) { oA[r] = 0.f; oB[r] = 0.f; }
        const int nvt = (cnt + 63) >> 6;
        const int tq = (ln & 15) >> 2, tp = ln & 3, tc = (ln >> 4) & 1;
#pragma unroll 1
        for (int vt = 0; vt < nvt; ++vt) {
#pragma unroll
            for (int i = 0; i < 8; ++i) *(u32x4*)(Vt + (8 * i + (ln >> 3)) * VTD_LD + 8 * (ln & 7)) = vr[i];
            asm volatile("s_waitcnt lgkmcnt(0)" ::: "memory");
            __builtin_amdgcn_wave_barrier();
            if (vt + 1 < nvt) DSA_VLOAD(vt + 1);
            const bf16_t* vtl = Vt + (8 * hia + tq) * VTD_LD + 16 * tc + 4 * tp;
            asm volatile("" : "+v"(vtl));
#pragma unroll
            for (int ks = 0; ks < 4; ++ks) {
                bf16x8 ap = *(const bf16x8*)(PWb + (l32a & 3) * PW_LD + 64 * vt + 16 * ks + 8 * hia);
                if (l32a >= 4) ap = (bf16x8){0, 0, 0, 0, 0, 0, 0, 0};
                const bf16_t* vrow = vtl + (16 * ks) * VTD_LD;
                const v4i16_t r1 = ds_tr16(vrow), r2 = ds_tr16(vrow + 4 * VTD_LD);
                const v4i16_t r3 = ds_tr16(vrow + 32), r4 = ds_tr16(vrow + 4 * VTD_LD + 32);
                const bf16x8 b0 = (bf16x8){r1[0], r1[1], r1[2], r1[3], r2[0], r2[1], r2[2], r2[3]};
                const bf16x8 b1 = (bf16x8){r3[0], r3[1], r3[2], r3[3], r4[0], r4[1], r4[2], r4[3]};
                oA = mfma32(ap, b0, oA); oB = mfma32(ap, b1, oB);
            }
            asm volatile("" : "+v"(oA), "+v"(oB));
            asm volatile("s_waitcnt lgkmcnt(0)" ::: "memory");
            __builtin_amdgcn_wave_barrier();
        }
#undef DSA_VLOAD
        if (hia == 0) {
            bf16_t* orow = MIX + row * DM + l32a;
#pragma unroll
            for (int hh = 0; hh < 4; ++hh) {
                const float il = 1.0f / lh[hh];
                orow[64 * hh] = (bf16_t)(pk2(oA[hh] * il, 0.f) & 0xffffu);
                orow[64 * hh + 32] = (bf16_t)(pk2(oB[hh] * il, 0.f) & 0xffffu);
            }
        }
        asm volatile("s_waitcnt lgkmcnt(0)" ::: "memory");
        __builtin_amdgcn_wave_barrier();
        }
    }
    __syncthreads();
}

constexpr int MB_VT = 0, MB_LIST = 8 * 64 * VTD_LD * 2, MB_WCNT = MB_LIST + 32 * 256 * 2, MB_END = MB_WCNT + 8 * 32 * 4;
static_assert(MB_END <= 131072 && FL_END <= MB_LIST, "MoBA LDS map");
constexpr int PART_LD = 68;
__device__ __forceinline__ void moba_unit(const bf16_t* __restrict__ P, const float* __restrict__ KMEAN, bf16_t* __restrict__ MIX, float* __restrict__ scr,
                                          int b, int h, int qt, char* lds) {
    int tid_ = threadIdx.x; asm volatile("" : "+v"(tid_));
    const int tid = tid_, lane = tid & 63, w = __builtin_amdgcn_readfirstlane(tid >> 6), l32 = lane & 31, hi = lane >> 5;
    constexpr int QOFF = BQ_OFF, KOFF = BK_OFF, VOFF = BV_OFF, OOFF = 256;
    const size_t rowbase = (size_t)b * SEQ;
    const int q0 = qt * 256 + w * 32, myq = q0 + l32, qlocal = w * 32 + l32;
    const bf16_t* qrow = P + (rowbase + myq) * NPROJ + QOFF + 64 * h;
    unsigned short* listb = (unsigned short*)(lds + MB_LIST);
    int* wcnt = (int*)(lds + MB_WCNT);
    bf16_t* Vt = (bf16_t*)(lds + MB_VT) + w * 64 * VTD_LD;
    int i1 = -1, i2 = -1, i3 = -1;
    {
        float v1 = -INFINITY, v2 = -INFINITY, v3 = -INFINITY;
        const float* km = KMEAN + ((size_t)(b * 4 + h) * 32) * 64;
        for (int n = 0; n < qt; ++n) {
            float gsum = 0.f;
#pragma unroll
            for (int c8 = 0; c8 < 8; ++c8) {
                const u32x4 qv = *(const u32x4*)(qrow + 8 * c8);
                const f32x4 k0 = *(const f32x4*)(km + n * 64 + 8 * c8), k1 = *(const f32x4*)(km + n * 64 + 8 * c8 + 4);
                gsum += __uint_as_float(qv.x << 16) * k0[0] + __uint_as_float(qv.x & 0xffff0000u) * k0[1] + __uint_as_float(qv.y << 16) * k0[2] + __uint_as_float(qv.y & 0xffff0000u) * k0[3]
                      + __uint_as_float(qv.z << 16) * k1[0] + __uint_as_float(qv.z & 0xffff0000u) * k1[1] + __uint_as_float(qv.w << 16) * k1[2] + __uint_as_float(qv.w & 0xffff0000u) * k1[3];
            }
            if (gsum > v3) {
                if (gsum > v1) { v3 = v2; i3 = i2; v2 = v1; i2 = i1; v1 = gsum; i1 = n; }
                else if (gsum > v2) { v3 = v2; i3 = i2; v2 = gsum; i2 = n; }
                else { v3 = gsum; i3 = n; }
            }
        }
    }
#ifdef DBG_ZERO_PART
    for (int i = tid; i < 256 * 3 * PART_LD / 4; i += NTHREADS) *(f32x4*)(scr + 4 * i) = (f32x4){0.f, 0.f, 0.f, 0.f};
#endif
    __syncthreads();
    for (int n = 0; n < qt; ++n) {
        const bool pr = (hi == 0) && (i1 == n || i2 == n || i3 == n);
        const unsigned long long mk = __ballot(pr);
        if (lane == 0) wcnt[w * 32 + n] = __builtin_popcountll(mk);
    }
    __syncthreads();
    for (int n = 0; n < qt; ++n) {
        const bool pr = (hi == 0) && (i1 == n || i2 == n || i3 == n);
        const unsigned long long mk = __ballot(pr);
        int base = 0;
        for (int ww = 0; ww < w; ++ww) base += wcnt[ww * 32 + n];
        if (pr) {
            const int slot = (i1 == n) ? 0 : ((i2 == n) ? 1 : 2);
            const int pre = __builtin_amdgcn_mbcnt_hi((unsigned)(mk >> 32), __builtin_amdgcn_mbcnt_lo((unsigned)mk, 0u));
            listb[n * 256 + base + pre] = (unsigned short)(qlocal | (slot << 8));
        }
    }
    __syncthreads();
    {
        const int tq = (lane & 15) >> 2, tp = lane & 3, tc = (lane >> 4) & 1;
        int it = 0;
#pragma unroll 1
        for (int n = 0; n < qt; ++n) {
            int cn = 0;
#pragma unroll
            for (int ww = 0; ww < 8; ++ww) cn += wcnt[ww * 32 + n];
            const int ng = (cn + 31) >> 5;
#pragma unroll 1
            for (int g = 0; g < ng; ++g, ++it) {
                if ((it & 7) != w) continue;
                const int j = 32 * g + l32; const bool valid = j < cn;
                const unsigned ent = listb[n * 256 + (valid ? j : 32 * g)];
                const int ql = (int)(ent & 255u), slot = (int)(ent >> 8);
                const bf16_t* qr = P + (rowbase + qt * 256 + ql) * NPROJ + QOFF + 64 * h;
                bf16x8 qf[4];
#pragma unroll
                for (int ks = 0; ks < 4; ++ks) qf[ks] = *(const bf16x8*)(qr + 16 * ks + 8 * hi);
                float m = -INFINITY, lsum = 0.f;
                f32x16 o0, o1;
#pragma unroll
                for (int r = 0; r < 16; ++r) { o0[r] = 0.f; o1[r] = 0.f; }
                const bf16_t* kb0 = P + (rowbase + 256 * n + l32) * NPROJ + KOFF + 64 * h + 8 * hi;
                const bf16_t* vb0 = P + (rowbase + 256 * n + (lane >> 3)) * NPROJ + VOFF + 64 * h + 8 * (lane & 7);
                bf16x8 ka[2][4]; u32x4 vr[8];
#define MB_LOADK(t_) do { _Pragma("unroll") for (int ks_ = 0; ks_ < 4; ++ks_) { ka[0][ks_] = *(const bf16x8*)(kb0 + (size_t)(64 * (t_)) * NPROJ + 16 * ks_); \
                                                                             ka[1][ks_] = *(const bf16x8*)(kb0 + (size_t)(64 * (t_) + 32) * NPROJ + 16 * ks_); } } while (0)
#define MB_LOADV(t_) do { _Pragma("unroll") for (int i_ = 0; i_ < 8; ++i_) vr[i_] = *(const u32x4*)(vb0 + (size_t)(64 * (t_) + 8 * i_) * NPROJ); } while (0)
                MB_LOADK(0); MB_LOADV(0);
#pragma unroll 1
                for (int t = 0; t < 4; ++t) {
                    f32x16 s0, s1;
#pragma unroll
                    for (int r = 0; r < 16; ++r) { s0[r] = 0.f; s1[r] = 0.f; }
#pragma unroll
                    for (int ks = 0; ks < 4; ++ks) { s0 = mfma32(ka[0][ks], qf[ks], s0); s1 = mfma32(ka[1][ks], qf[ks], s1); }
                    asm volatile("" : "+v"(s0), "+v"(s1));
                    if (t + 1 < 4) MB_LOADK(t + 1);
#pragma unroll
                    for (int i = 0; i < 8; ++i) *(u32x4*)(Vt + (8 * i + (lane >> 3)) * VTD_LD + 8 * (lane & 7)) = vr[i];
                    asm volatile("s_waitcnt lgkmcnt(0)" ::: "memory");
                    __builtin_amdgcn_wave_barrier();
                    float mxa = max3f(s0[0], s0[1], s0[2]), mxb = max3f(s1[0], s1[1], s1[2]);
#pragma unroll
                    for (int r = 3; r < 15; r += 2) { mxa = max3f(mxa, s0[r], s0[r + 1]); mxb = max3f(mxb, s1[r], s1[r + 1]); }
                    float mx = max3f(mxa, mxb, s0[15]); mx = max2f(mx, s1[15]);
                    mx = max2f(mx, __shfl_xor(mx, 32));
                    const float mnew = max2f(m, mx);
                    const float alpha = fexp2(m - mnew);
                    float psum = 0.f;
#pragma unroll
                    for (int r = 0; r < 16; ++r) { s0[r] = fexp2(s0[r] - mnew); s1[r] = fexp2(s1[r] - mnew); psum += s0[r] + s1[r]; }
                    lsum = lsum * alpha + psum; m = mnew;
#pragma unroll
                    for (int r = 0; r < 16; ++r) { o0[r] *= alpha; o1[r] *= alpha; }
                    bf16x8 pk[4];
                    {
                        u32x4 tt;
                        tt.x = pk2(s0[0], s0[1]); tt.y = pk2(s0[2], s0[3]); tt.z = pk2(s0[4], s0[5]); tt.w = pk2(s0[6], s0[7]); pk[0] = __builtin_bit_cast(bf16x8, tt);
                        tt.x = pk2(s0[8], s0[9]); tt.y = pk2(s0[10], s0[11]); tt.z = pk2(s0[12], s0[13]); tt.w = pk2(s0[14], s0[15]); pk[1] = __builtin_bit_cast(bf16x8, tt);
                        tt.x = pk2(s1[0], s1[1]); tt.y = pk2(s1[2], s1[3]); tt.z = pk2(s1[4], s1[5]); tt.w = pk2(s1[6], s1[7]); pk[2] = __builtin_bit_cast(bf16x8, tt);
                        tt.x = pk2(s1[8], s1[9]); tt.y = pk2(s1[10], s1[11]); tt.z = pk2(s1[12], s1[13]); tt.w = pk2(s1[14], s1[15]); pk[3] = __builtin_bit_cast(bf16x8, tt);
                    }
                    asm volatile("" : "+v"(pk[0]), "+v"(pk[1]), "+v"(pk[2]), "+v"(pk[3]));
                    const bf16_t* vtl = Vt + (4 * hi + tq) * VTD_LD + 16 * tc + 4 * tp;
                    asm volatile("" : "+v"(vtl));
#pragma unroll
                    for (int kk = 0; kk < 4; ++kk) {
                        const bf16_t* vrow = vtl + (16 * kk) * VTD_LD;
                        const v4i16_t r1 = ds_tr16(vrow), r2 = ds_tr16(vrow + 8 * VTD_LD);
                        const v4i16_t r3 = ds_tr16(vrow + 32), r4 = ds_tr16(vrow + 8 * VTD_LD + 32);
                        const bf16x8 a0 = (bf16x8){r1[0], r1[1], r1[2], r1[3], r2[0], r2[1], r2[2], r2[3]};
                        const bf16x8 a1 = (bf16x8){r3[0], r3[1], r3[2], r3[3], r4[0], r4[1], r4[2], r4[3]};
                        o0 = mfma32(a0, pk[kk], o0); o1 = mfma32(a1, pk[kk], o1);
                    }
                    asm volatile("" : "+v"(o0), "+v"(o1));
                    asm volatile("s_waitcnt lgkmcnt(0)" ::: "memory");
                    __builtin_amdgcn_wave_barrier();
                    if (t + 1 < 4) MB_LOADV(t + 1);
                }
#undef MB_LOADK
#undef MB_LOADV
                const float ltot = lsum + __shfl_xor(lsum, 32);
                if (valid) {
                    float* pb = scr + (size_t)(ql * 3 + slot) * PART_LD;
#pragma unroll
                    for (int g4 = 0; g4 < 4; ++g4) {
                        f32x4 x0, x1;
                        x0[0] = o0[4 * g4]; x0[1] = o0[4 * g4 + 1]; x0[2] = o0[4 * g4 + 2]; x0[3] = o0[4 * g4 + 3];
                        x1[0] = o1[4 * g4]; x1[1] = o1[4 * g4 + 1]; x1[2] = o1[4 * g4 + 2]; x1[3] = o1[4 * g4 + 3];
                        *(f32x4*)(pb + 8 * g4 + 4 * hi) = x0; *(f32x4*)(pb + 32 + 8 * g4 + 4 * hi) = x1;
                    }
                    if (hi == 0) { pb[64] = m; pb[65] = ltot; }
                }
            }
        }
    }
    __syncthreads();
    __builtin_amdgcn_fence(__ATOMIC_ACQUIRE, "agent");
    bf16x8 qf[4];
#pragma unroll
    for (int ks = 0; ks < 4; ++ks) qf[ks] = *(const bf16x8*)(qrow + 16 * ks + 8 * hi);
    float m = -INFINITY, lsum = 0.f;
    f32x16 o0, o1;
#pragma unroll
    for (int r = 0; r < 16; ++r) { o0[r] = 0.f; o1[r] = 0.f; }
    const int NT = 4 * qt + 4;
    const int kkey = tid >> 3, kch = tid & 7;
    const int vkey = 16 * (w & 3) + (lane & 15), vch = 4 * (w >> 2) + (lane >> 4);
    u32x4 kreg, vreg;
#define MBF_LOAD(kt_) do { kreg = *(const u32x4*)(P + (rowbase + 64 * (kt_) + kkey) * NPROJ + KOFF + 64 * h + 8 * kch); \
        vreg = *(const u32x4*)(P + (rowbase + 64 * (kt_) + vkey) * NPROJ + VOFF + 64 * h + 8 * vch); } while (0)
#define MBF_STORE(buf_) do { bf16_t* Kd_ = (bf16_t*)(lds + (buf_) * FL_BUF + FL_KS); bf16_t* Vd_ = (bf16_t*)(lds + (buf_) * FL_BUF + FL_VT); \
        *(u32x4*)(Kd_ + kkey * KS_LD + 8 * kch) = kreg; \
        bf16_t* vd = Vd_ + (8 * vch) * VT_LD + vkey; \
        vd[0 * VT_LD] = (bf16_t)(vreg.x & 0xffffu); vd[1 * VT_LD] = (bf16_t)(vreg.x >> 16); \
        vd[2 * VT_LD] = (bf16_t)(vreg.y & 0xffffu); vd[3 * VT_LD] = (bf16_t)(vreg.y >> 16); \
        vd[4 * VT_LD] = (bf16_t)(vreg.z & 0xffffu); vd[5 * VT_LD] = (bf16_t)(vreg.z >> 16); \
        vd[6 * VT_LD] = (bf16_t)(vreg.w & 0xffffu); vd[7 * VT_LD] = (bf16_t)(vreg.w >> 16); } while (0)
    int kt = 4 * qt;
    MBF_LOAD(kt);
    MBF_STORE(0);
    __syncthreads();
    int cur = 0;
    while (kt < NT) {
        const int ktc = kt;
        if (kt + 1 < NT) MBF_LOAD(kt + 1);
        ++kt;
        const bf16_t* Ks = (const bf16_t*)(lds + cur * FL_BUF + FL_KS); const bf16_t* VT = (const bf16_t*)(lds + cur * FL_BUF + FL_VT);
        if (!(64 * ktc > q0 + 31)) {
            f32x16 s0, s1;
#pragma unroll
            for (int r = 0; r < 16; ++r) { s0[r] = 0.f; s1[r] = 0.f; }
#pragma unroll
            for (int ks = 0; ks < 4; ++ks) {
                const bf16x8 a0 = *(const bf16x8*)(Ks + l32 * KS_LD + 16 * ks + 8 * hi);
                const bf16x8 a1 = *(const bf16x8*)(Ks + (32 + l32) * KS_LD + 16 * ks + 8 * hi);
                s0 = mfma32(a0, qf[ks], s0); s1 = mfma32(a1, qf[ks], s1);
            }
            if (64 * ktc + 63 > q0) {
#pragma unroll
                for (int r = 0; r < 16; ++r) {
                    const int kg = 64 * ktc + 8 * (r >> 2) + 4 * hi + (r & 3);
                    if (kg > myq) s0[r] = -INFINITY;
                    if (kg + 32 > myq) s1[r] = -INFINITY;
                }
            }
            float mxa = max3f(s0[0], s0[1], s0[2]), mxb = max3f(s1[0], s1[1], s1[2]);
#pragma unroll
            for (int r = 3; r < 15; r += 2) { mxa = max3f(mxa, s0[r], s0[r + 1]); mxb = max3f(mxb, s1[r], s1[r + 1]); }
            float mx = max3f(mxa, mxb, s0[15]); mx = max2f(mx, s1[15]);
            mx = max2f(mx, __shfl_xor(mx, 32));
            const float mnew = max2f(m, mx);
            const float msafe = (mnew == -INFINITY) ? 0.f : mnew;
            const float alpha = fexp2(m - msafe);
            float psum = 0.f;
#pragma unroll
            for (int r = 0; r < 16; ++r) { s0[r] = fexp2(s0[r] - msafe); s1[r] = fexp2(s1[r] - msafe); psum += s0[r] + s1[r]; }
            lsum = lsum * alpha + psum; m = mnew;
#pragma unroll
            for (int r = 0; r < 16; ++r) { o0[r] *= alpha; o1[r] *= alpha; }
            bf16x8 pk[4];
            {
                u32x4 tt;
                tt.x = pk2(s0[0], s0[1]); tt.y = pk2(s0[2], s0[3]); tt.z = pk2(s0[4], s0[5]); tt.w = pk2(s0[6], s0[7]); pk[0] = __builtin_bit_cast(bf16x8, tt);
                tt.x = pk2(s0[8], s0[9]); tt.y = pk2(s0[10], s0[11]); tt.z = pk2(s0[12], s0[13]); tt.w = pk2(s0[14], s0[15]); pk[1] = __builtin_bit_cast(bf16x8, tt);
                tt.x = pk2(s1[0], s1[1]); tt.y = pk2(s1[2], s1[3]); tt.z = pk2(s1[4], s1[5]); tt.w = pk2(s1[6], s1[7]); pk[2] = __builtin_bit_cast(bf16x8, tt);
                tt.x = pk2(s1[8], s1[9]); tt.y = pk2(s1[10], s1[11]); tt.z = pk2(s1[12], s1[13]); tt.w = pk2(s1[14], s1[15]); pk[3] = __builtin_bit_cast(bf16x8, tt);
            }
#pragma unroll
            for (int kk = 0; kk < 4; ++kk) {
                u32x4 a, c;
                const u32x2 a_lo = *(const u32x2*)(VT + l32 * VT_LD + 16 * kk + 4 * hi), a_hi = *(const u32x2*)(VT + l32 * VT_LD + 16 * kk + 8 + 4 * hi);
                const u32x2 c_lo = *(const u32x2*)(VT + (32 + l32) * VT_LD + 16 * kk + 4 * hi), c_hi = *(const u32x2*)(VT + (32 + l32) * VT_LD + 16 * kk + 8 + 4 * hi);
                a.x = a_lo.x; a.y = a_lo.y; a.z = a_hi.x; a.w = a_hi.y; c.x = c_lo.x; c.y = c_lo.y; c.z = c_hi.x; c.w = c_hi.y;
                o0 = mfma32(__builtin_bit_cast(bf16x8, a), pk[kk], o0);
                o1 = mfma32(__builtin_bit_cast(bf16x8, c), pk[kk], o1);
            }
        }
        if (kt < NT) MBF_STORE(cur ^ 1);
        __syncthreads();
        cur ^= 1;
    }
#undef MBF_LOAD
#undef MBF_STORE
    float ltot = lsum + __shfl_xor(lsum, 32);
#pragma unroll
    for (int sl = 0; sl < 3; ++sl) {
        const int bi = (sl == 0) ? i1 : ((sl == 1) ? i2 : i3);
#ifdef DBG_NOMERGE
        if (bi >= 1000 + (int)blockIdx.x) {
#else
        if (bi >= 0) {
#endif
            float* pb = scr + (size_t)(qlocal * 3 + sl) * PART_LD;
            const float mp = pb[64], lp = pb[65];
            const float mn = max2f(m, mp);
            const float fa = fexp2(m - mn), fb = fexp2(mp - mn);
            ltot = ltot * fa + lp * fb; m = mn;
#pragma unroll
            for (int g4 = 0; g4 < 4; ++g4) {
                const f32x4 x0 = *(const f32x4*)(pb + 8 * g4 + 4 * hi), x1 = *(const f32x4*)(pb + 32 + 8 * g4 + 4 * hi);
#pragma unroll
                for (int i = 0; i < 4; ++i) { o0[4 * g4 + i] = o0[4 * g4 + i] * fa + x0[i] * fb; o1[4 * g4 + i] = o1[4 * g4 + i] * fa + x1[i] * fb; }
            }
        }
    }
    const float inv = 1.0f / ltot;
    bf16_t* orow = MIX + (rowbase + myq) * DM + OOFF + 64 * h;
#pragma unroll
    for (int g4 = 0; g4 < 4; ++g4) {
        const int d = 8 * g4 + 4 * hi;
        u32x2 wa, wc2;
        wa.x = pk2(o0[4 * g4] * inv, o0[4 * g4 + 1] * inv); wa.y = pk2(o0[4 * g4 + 2] * inv, o0[4 * g4 + 3] * inv);
        wc2.x = pk2(o1[4 * g4] * inv, o1[4 * g4 + 1] * inv); wc2.y = pk2(o1[4 * g4 + 2] * inv, o1[4 * g4 + 3] * inv);
        *(u32x2*)(orow + d) = wa; *(u32x2*)(orow + 32 + d) = wc2;
    }
    __syncthreads();
}

constexpr int UNITS_PER_LEVEL = 8 + 4 + 8, N_ATT_UNITS = 32 * UNITS_PER_LEVEL;
__device__ __forceinline__ void attn_phase(const bf16_t* P, const float* IW, const float* CUM, const float* KMEAN, bf16_t* MIX, float* scr, unsigned* counters, const float* gq, const float* gk, char* lds) {
    int* s_unit = (int*)(lds + MISC_OFF);
    for (int qi = 0; qi < NB; ++qi) {
        const int b = (int)((blockIdx.x + qi) & (NB - 1));
        unsigned* counter = counters + 64 * b;
        for (;;) {
            __syncthreads();
            if (threadIdx.x == 0) *s_unit = (int)atomicAdd(counter, 1u);
            __syncthreads();
            const int u = *s_unit;
            if (u >= N_ATT_UNITS) break;
            const int lvl = 31 - u / UNITS_PER_LEVEL, j = u % UNITS_PER_LEVEL;
            int reps_f = 1, reps_d = 1;
#ifdef PROBE_FLASH2
            reps_f = 2;
#endif
#ifdef PROBE_DSA2
            reps_d = 2;
#endif
#pragma unroll 1
            for (int rep_ = 0; rep_ < (j < 12 ? reps_f : reps_d); ++rep_) {
                if (j < 8) flash_unit<0>(P, CUM, KMEAN, MIX, gq, gk, b, j, lvl, lds);
#ifdef MOBA_DENSE
                else if (j < 12) flash_unit<1>(P, CUM, KMEAN, MIX, gq, gk, b, j - 8, lvl, lds);
#else
                else if (j < 12) moba_unit(P, KMEAN, MIX, scr, b, j - 8, lvl, lds);
#endif
                else dsa_unit(P, IW, MIX, scr, b, 8 * lvl + (j - 12), lds);
            }
        }
    }
}

constexpr int N_PHASES = 1 + 8 * DEPTH;
#define PH_IN(p) (lo <= (p) && (p) < hi)
#define PH_SYNC(p) do { if (PH_IN(p) && PH_IN((p) + 1)) cg::this_grid().sync(); } while (0)
__device__ __forceinline__ void prologue_phase(const Args& args, char* lds) {
    unsigned char* ws = args.ws;
    const int tid = threadIdx.x, lane = tid & 63, wave = tid >> 6;
    float* scr = (float*)(lds + wave * 16384);
    const int gw = blockIdx.x * 8 + wave, ngw = gridDim.x * 8;
    for (int mat = 0; mat < 16; ++mat) {
        const int l = mat >> 3, k = mat & 7;
        const float* src; const float* gain = nullptr; int K, N, kind; size_t dst;
        if (k == 0) { src = args.in[2] + (size_t)l * DM * DFF; gain = args.in[1] + l * DM; K = DM; N = DFF; kind = 1; dst = WL_GU1; }
        else if (k == 1) { src = args.in[3] + (size_t)l * DM * DFF; gain = args.in[1] + l * DM; K = DM; N = DFF; kind = 2; dst = WL_GU1; }
        else if (k == 2) { src = args.in[4] + (size_t)l * DFF * DM; K = DFF; N = DM; kind = 0; dst = WL_D1; }
        else if (k == 3) { src = args.in[16] + (size_t)l * DM * DFF; gain = args.in[15] + l * DM; K = DM; N = DFF; kind = 1; dst = WL_GU2; }
        else if (k == 4) { src = args.in[17] + (size_t)l * DM * DFF; gain = args.in[15] + l * DM; K = DM; N = DFF; kind = 2; dst = WL_GU2; }
        else if (k == 5) { src = args.in[18] + (size_t)l * DFF * DM; K = DFF; N = DM; kind = 0; dst = WL_D2; }
        else if (k == 6) { src = args.in[6] + (size_t)l * DM * INW; gain = args.in[5] + l * DM; K = DM; N = INW; kind = 3; dst = WL_IN; }
        else { src = args.in[14] + (size_t)l * DM * DM; K = DM; N = DM; kind = 0; dst = WL_OUT; }
        bf16_t* WT = (bf16_t*)(ws + WS_W + (size_t)l * WL_BYTES + dst);
        const int nitems = (K / 64) * ((N + 31) / 32);
        for (int it = gw; it < nitems; it += ngw) transpose_item(src, gain, K, N, WT, kind, scr, it, lane);
    }
    for (int i = blockIdx.x * NTHREADS + tid; i < DEPTH * 48 * 128; i += gridDim.x * NTHREADS) {
        const int l = i / (48 * 128), r = (i / 128) % 48, c = i % 128, d = 16 + r;
        bf16_t* WT = (bf16_t*)(ws + WS_W + (size_t)l * WL_BYTES + WL_IN);
        *(u32x4*)(WT + (size_t)(256 * 14 + 128 * (d >> 5) + 96 + (d & 31)) * DM + 8 * c) = (u32x4){0u, 0u, 0u, 0u};
    }
    if (blockIdx.x == 0 && tid < 2 * NB) ((unsigned*)(ws + WS_CTL))[64 * tid] = 0u;
    float* COS = (float*)(ws + WS_COS); float* SIN = (float*)(ws + WS_SIN);
    for (int i = blockIdx.x * NTHREADS + tid; i < SEQ * 32; i += gridDim.x * NTHREADS) {
        const int pos = i >> 5, f = i & 31;
        const float inv = 1.0f / powf(10000.0f, (float)(2 * f) / 64.0f);
        const float ang = (float)pos * inv;
        COS[i] = (float)cos((double)ang); SIN[i] = (float)sin((double)ang);
    }
    float* SS = (float*)(ws + WS_SS);
    for (int m0 = 4 * gw; m0 < MTOK; m0 += 4 * ngw) {
        f32x4 v[4][4];
#pragma unroll
        for (int r = 0; r < 4; ++r)
#pragma unroll
            for (int j = 0; j < 4; ++j) v[r][j] = *((const f32x4*)(args.in[0] + (size_t)(m0 + r) * DM) + lane + 64 * j);
#pragma unroll
        for (int r = 0; r < 4; ++r) {
            float sq = 0.f;
#pragma unroll
            for (int j = 0; j < 4; ++j) sq += (v[r][j][0] * v[r][j][0] + v[r][j][1] * v[r][j][1]) + (v[r][j][2] * v[r][j][2] + v[r][j][3] * v[r][j][3]);
            sq = wave_sum(sq);
            u32x2* o8 = (u32x2*)((bf16_t*)(ws + WS_XN) + (size_t)(m0 + r) * DM) + lane;
#pragma unroll
            for (int j = 0; j < 4; ++j) { u32x2 wv; wv.x = pk2(v[r][j][0], v[r][j][1]); wv.y = pk2(v[r][j][2], v[r][j][3]); o8[64 * j] = wv; }
            if (lane < 16) SS[(size_t)(m0 + r) * 16 + lane] = (lane == 0) ? sq : 0.f;
        }
    }
}
template <int L>
__device__ __forceinline__ void layer_phases(const Args& args, unsigned char* lds_raw, const int lo, const int hi) {
    char* lds = (char*)lds_raw;
    unsigned char* ws = args.ws;
    constexpr int P0 = 1 + 8 * L;
    float* SSb = (float*)(ws + WS_SS);
    if (PH_IN(P0 + 0)) {
        pg8::Gemm g{(const bf16_t*)(ws + WS_XN), (const bf16_t*)(ws + WS_W + (size_t)L * WL_BYTES + WL_GU1), MTOK, 2 * DFF, DM};
        pg8::StaticOrder S; S.init(MTOK, 2 * DFF, (int)gridDim.x, (int)blockIdx.x);
        EpiSwiglu E{(bf16_t*)(ws + WS_BIG), SSb + (size_t)(3 * L + 0) * MTOK * 16};
        pg8::gemm_phase<EpiSwiglu, pg8::StaticOrder, true, true>((PG8_LAS unsigned char*)lds_raw, g, S, E);
#ifdef PROBE_GU2
        __syncthreads();
        pg8::gemm_phase<EpiSwiglu, pg8::StaticOrder, true, true>((PG8_LAS unsigned char*)lds_raw, g, S, E);
#endif
    }
    PH_SYNC(P0 + 0);
    if (PH_IN(P0 + 1)) {
        pg8::Gemm g{(const bf16_t*)(ws + WS_BIG), (const bf16_t*)(ws + WS_W + (size_t)L * WL_BYTES + WL_D1), MTOK, DM, DFF};
        pg8::StaticOrder S; S.init(MTOK, DM, (int)gridDim.x, (int)blockIdx.x);
        EpiResid<true, 1> E{L == 0 ? args.in[0] : args.out, args.out, (bf16_t*)(ws + WS_XN), SSb + (size_t)(3 * L + 1) * MTOK * 16};
        pg8::gemm_phase<EpiResid<true, 1>, pg8::StaticOrder, false, true>((PG8_LAS unsigned char*)lds_raw, g, S, E);
    }
    PH_SYNC(P0 + 1);
    if (PH_IN(P0 + 2)) {
        pg8::Gemm g{(const bf16_t*)(ws + WS_XN), (const bf16_t*)(ws + WS_W + (size_t)L * WL_BYTES + WL_IN), MTOK, NPROJ, DM};
        pg8::StaticOrder S; S.init(MTOK, NPROJ, (int)gridDim.x, (int)blockIdx.x);
        EpiProj E{(bf16_t*)(ws + WS_BIG), (float*)(ws + WS_IW), (float*)(ws + WS_LF), (const float*)(ws + WS_COS), (const float*)(ws + WS_SIN),
                  args.in[8] + L * 64, args.in[9] + L * 64, args.in[10] + L * 64, args.in[11] + L * 64, args.in[12] + L * 64, args.in[13] + L * 64, args.in[7] + L * 8,
                  SSb + (size_t)(3 * L + 1) * MTOK * 16};
        pg8::gemm_phase<EpiProj, pg8::StaticOrder, true, true>((PG8_LAS unsigned char*)lds_raw, g, S, E);
#ifdef PROBE_IN2
        __syncthreads();
        pg8::gemm_phase<EpiProj, pg8::StaticOrder, true, true>((PG8_LAS unsigned char*)lds_raw, g, S, E);
#endif
    }
    PH_SYNC(P0 + 2);
    if (PH_IN(P0 + 3)) scan_kmean_phase((const float*)(ws + WS_LF), (float*)(ws + WS_CUM), (const bf16_t*)(ws + WS_BIG), (float*)(ws + WS_KMEAN), lds);
#ifdef PROBE_SCAN2
    if (PH_IN(P0 + 3)) { __syncthreads(); scan_kmean_phase((const float*)(ws + WS_LF), (float*)(ws + WS_CUM), (const bf16_t*)(ws + WS_BIG), (float*)(ws + WS_KMEAN), lds); }
#endif
    PH_SYNC(P0 + 3);
    if (PH_IN(P0 + 4))
        attn_phase((const bf16_t*)(ws + WS_BIG), (const float*)(ws + WS_IW), (const float*)(ws + WS_CUM), (const float*)(ws + WS_KMEAN), (bf16_t*)(ws + WS_XN),
                   (float*)(ws + WS_SCR) + (size_t)blockIdx.x * 32 * SEQ, (unsigned*)(ws + WS_CTL) + 64 * 8 * L, args.in[12] + L * 64, args.in[13] + L * 64, lds);
    PH_SYNC(P0 + 4);
    if (PH_IN(P0 + 5)) {
        pg8::Gemm g{(const bf16_t*)(ws + WS_XN), (const bf16_t*)(ws + WS_W + (size_t)L * WL_BYTES + WL_OUT), MTOK, DM, DM};
        pg8::StaticOrder S; S.init(MTOK, DM, (int)gridDim.x, (int)blockIdx.x);
        EpiResid<true, 2> E{args.out, args.out, (bf16_t*)(ws + WS_HBB), SSb + (size_t)(3 * L + 2) * MTOK * 16};
        pg8::gemm_phase<EpiResid<true, 2>, pg8::StaticOrder, false, true>((PG8_LAS unsigned char*)lds_raw, g, S, E);
    }
    PH_SYNC(P0 + 5);
    if (PH_IN(P0 + 6)) {
        pg8::Gemm g{(const bf16_t*)(ws + WS_HBB), (const bf16_t*)(ws + WS_W + (size_t)L * WL_BYTES + WL_GU2), MTOK, 2 * DFF, DM};
        pg8::StaticOrder S; S.init(MTOK, 2 * DFF, (int)gridDim.x, (int)blockIdx.x);
        EpiSwiglu E{(bf16_t*)(ws + WS_BIG), SSb + (size_t)(3 * L + 2) * MTOK * 16};
        pg8::gemm_phase<EpiSwiglu, pg8::StaticOrder, true, true>((PG8_LAS unsigned char*)lds_raw, g, S, E);
    }
    PH_SYNC(P0 + 6);
    if (PH_IN(P0 + 7)) {
        pg8::Gemm g{(const bf16_t*)(ws + WS_BIG), (const bf16_t*)(ws + WS_W + (size_t)L * WL_BYTES + WL_D2), MTOK, DM, DFF};
        pg8::StaticOrder S; S.init(MTOK, DM, (int)gridDim.x, (int)blockIdx.x);
        EpiResid<(L + 1 < DEPTH), 1> E{args.out, args.out, (bf16_t*)(ws + WS_XN), SSb + (size_t)(3 * (L + 1 < DEPTH ? L + 1 : 0)) * MTOK * 16};
        pg8::gemm_phase<EpiResid<(L + 1 < DEPTH), 1>, pg8::StaticOrder, false, true>((PG8_LAS unsigned char*)lds_raw, g, S, E);
    }
    PH_SYNC(P0 + 7);
}
__global__ void __launch_bounds__(NTHREADS, 2) fwd_kernel(Args args) {
    extern __shared__ __attribute__((aligned(16))) unsigned char lds_raw[];
    const int lo = args.ph_lo, hi = args.ph_hi;
    if (PH_IN(0)) prologue_phase(args, (char*)lds_raw);
#ifdef PROBE_PRO2
    if (PH_IN(0)) { __syncthreads(); prologue_phase(args, (char*)lds_raw); }
#endif
    PH_SYNC(0);
    layer_phases<0>(args, lds_raw, lo, hi);
    layer_phases<1>(args, lds_raw, lo, hi);
}

extern "C" void kernel_launch(void* const* d_in, const int* in_sizes, int n_in, void* d_out, int out_size, void* d_ws, size_t ws_size, hipStream_t stream) {
    static int grid = 0;
    if (grid == 0) {
        if (n_in != 19 || out_size != MTOK * DM || ws_size < WS_END) { fprintf(stderr, "kernel_launch: unexpected shapes (n_in %d out %d ws %zu)\n", n_in, out_size, ws_size); grid = -1; return; }
        int dev = 0, cus = 0, per_cu = 0;
        hipGetDevice(&dev); hipDeviceGetAttribute(&cus, hipDeviceAttributeMultiprocessorCount, dev);
        hipFuncSetAttribute((const void*)fwd_kernel, hipFuncAttributeMaxDynamicSharedMemorySize, LDS_BYTES);
        hipOccupancyMaxActiveBlocksPerMultiprocessor(&per_cu, (const void*)fwd_kernel, NTHREADS, LDS_BYTES);
        (void)hipGetLastError();
        grid = cus * (per_cu < 1 ? 1 : 1);
        if (grid > 256) grid = 256;
        if (grid < 1) grid = 256;
    }
    if (grid < 0) return;
    Args a{};
    for (int i = 0; i < 19; ++i) a.in[i] = (const float*)d_in[i];
    a.out = (float*)d_out; a.ws = (unsigned char*)d_ws;
#if MK_ONE_LAUNCH
    a.ph_lo = 0; a.ph_hi = N_PHASES;
    void* kargs[] = {&a};
    hipError_t e = hipLaunchCooperativeKernel((const void*)fwd_kernel, dim3(grid), dim3(NTHREADS), kargs, LDS_BYTES, stream);
    if (e != hipSuccess) fprintf(stderr, "cooperative launch failed: %s (grid %d)\n", hipGetErrorString(e), grid);
#else
    for (int ph = 0; ph < N_PHASES; ++ph) {
        a.ph_lo = ph; a.ph_hi = ph + 1;
        hipLaunchKernelGGL(fwd_kernel, dim3(grid), dim3(NTHREADS), LDS_BYTES, stream, a);
    }
#endif
}
```
